# Optimizing an MI355X kernel written in HIP

```python
import jax
import jax.numpy as jnp
from jax import lax
import numpy as np

D_MODEL = 1024
BATCH = 16
SEQ = 2048
DEPTH = 2

GRID_W = 64
CTX_LEN = 256
BLOCK = 128
WINDOW = 128
ROPE_THETA = 10000.0
EPS = 1e-6
NEG_INF = -1e30
N_MOD = 6

MLA_HEADS = 8
MLA_NOPE = 64
MLA_ROPE = 32
MLA_QK = MLA_NOPE + MLA_ROPE
MLA_V = 64
MLA_Q_RANK = 256
MLA_KV_RANK = 128

LRU_WIDTH = 512
LRU_BLOCKS = 8
LRU_BLOCK_DIM = LRU_WIDTH // LRU_BLOCKS
LRU_C = 8.0
CONV_W = 4

SWA_HEADS = 8
SWA_KV_HEADS = 2
SWA_GROUP = SWA_HEADS // SWA_KV_HEADS
SWA_HEAD_DIM = 64
SWA_KV_DIM = SWA_KV_HEADS * SWA_HEAD_DIM

GROUP_WIDTH = 512
MIX_WIDTH = 3 * GROUP_WIDTH
D_FF = 4 * D_MODEL
IN_SIZES = (MLA_Q_RANK, MLA_KV_RANK, MLA_ROPE, LRU_WIDTH, LRU_WIDTH, SWA_HEADS * SWA_HEAD_DIM, SWA_KV_DIM, SWA_KV_DIM)
IN_WIDTH = sum(IN_SIZES)

kernel_name = "hybrid_mla_rglru_swa_dit_block"


def rms_norm(x, g):
    xf = x.astype(jnp.float32)
    y = xf * lax.rsqrt(jnp.mean(xf * xf, axis=-1, keepdims=True) + EPS)
    return (y * g.astype(jnp.float32)).astype(x.dtype)


def modulate(x, g, shift, scale):
    return rms_norm(x, g) * (1 + scale) + shift


def axial_rope_tables(rows, dim):
    quarter = dim // 4
    n = rows * GRID_W
    row = jnp.repeat(jnp.arange(rows), GRID_W)
    col = jnp.tile(jnp.arange(GRID_W), rows)
    inv_freq = ROPE_THETA ** (-jnp.arange(quarter, dtype=jnp.float32) / quarter)
    ang = jnp.stack([row, col], axis=-1).astype(jnp.float32)[:, :, None] * inv_freq
    ang = jnp.broadcast_to(ang[:, :, None, :], (n, 2, 2, quarter)).reshape(n, dim)
    return jnp.cos(ang), jnp.sin(ang)


def apply_axial_rope(x, rope):
    cos, sin = rope
    d = x.shape[-1]
    xa = x.reshape(x.shape[:-1] + (2, 2, d // 4))
    rot = jnp.concatenate([-xa[..., 1:, :], xa[..., :1, :]], axis=-2).reshape(x.shape)
    return (x * cos[:, None, :] + rot * sin[:, None, :]).astype(x.dtype)


def split_columns(p):
    parts, start = [], 0
    for size in IN_SIZES:
        parts.append(p[..., start:start + size])
        start += size
    return parts


def mla_query(cq, q_a_g, w_uq, q_g, rope):
    B, L, _ = cq.shape
    q = rms_norm((rms_norm(cq, q_a_g) @ w_uq).reshape(B, L, MLA_HEADS, MLA_QK), q_g)
    if rope is not None:
        q = jnp.concatenate([q[..., :MLA_NOPE], apply_axial_rope(q[..., MLA_NOPE:], rope)], axis=-1)
    return q


def mla_key_value(ckv, k_rope, kv_a_g, w_ukv, k_g, rope):
    B, L, _ = ckv.shape
    kv = (rms_norm(ckv, kv_a_g) @ w_ukv).reshape(B, L, MLA_HEADS, MLA_NOPE + MLA_V)
    k_shared = jnp.broadcast_to(k_rope[:, :, None, :], (B, L, MLA_HEADS, MLA_ROPE))
    k = rms_norm(jnp.concatenate([kv[..., :MLA_NOPE], k_shared], axis=-1), k_g)
    if rope is not None:
        k = jnp.concatenate([k[..., :MLA_NOPE], apply_axial_rope(k[..., MLA_NOPE:], rope)], axis=-1)
    return k, kv[..., MLA_NOPE:]


def dense_block_attention(q, k, v):
    B, L, H, dq = q.shape
    nb = L // BLOCK
    scale = dq ** -0.5
    qb = q.reshape(B, nb, BLOCK, H, dq).transpose(1, 0, 2, 3, 4)

    def one_block(q_blk):
        s = jnp.einsum('bqhd,bkhd->bhqk', q_blk, k).astype(jnp.float32) * scale
        p = jax.nn.softmax(s, axis=-1).astype(v.dtype)
        return jnp.einsum('bhqk,bkhd->bqhd', p, v)

    o = lax.map(one_block, qb)
    return o.transpose(1, 0, 2, 3, 4).reshape(B, L, H * v.shape[-1])


def centred_depthwise_conv(x, w, b):
    left = CONV_W // 2
    y = lax.conv_general_dilated(x, w[:, None, :], window_strides=(1,), padding=[(left, CONV_W - 1 - left)],
                                 dimension_numbers=('NWC', 'WIO', 'NWC'), feature_group_count=x.shape[-1])
    return y + b


def rglru_coefficients(x, gate_w, gate_b, lam):
    B, L, W = x.shape
    xb = x.reshape(B, L, LRU_BLOCKS, LRU_BLOCK_DIM)
    g = jnp.einsum('blnc,zgncm->zgblnm', xb, gate_w).reshape(2, 2, B, L, W)
    g = jax.nn.sigmoid((g + gate_b[:, :, None, None, :]).astype(jnp.float32))
    r, i = g[:, 0], g[:, 1]
    log_a = -LRU_C * r * jax.nn.softplus(-lam.astype(jnp.float32))[:, None, None, :]
    a = jnp.exp(log_a)
    u = jnp.sqrt(-jnp.expm1(2.0 * log_a)) * (i * x.astype(jnp.float32)[None])
    return a, u


def linear_scan(a, u, h0, reverse):
    def combine(e1, e2):
        a1, u1 = e1
        a2, u2 = e2
        return a1 * a2, a2 * u1 + u2

    a_cum, h = lax.associative_scan(combine, (a, u), reverse=reverse, axis=1)
    return a_cum * h0[:, None, :] + h


def swa_query(sq, q_g, rope):
    B, L, _ = sq.shape
    q = rms_norm(sq.reshape(B, L, SWA_HEADS, SWA_HEAD_DIM), q_g)
    if rope is not None:
        q = apply_axial_rope(q, rope)
    return q.reshape(B, L, SWA_KV_HEADS, SWA_GROUP, SWA_HEAD_DIM)


def swa_key_value(sk, sv, k_g, rope):
    B, L, _ = sk.shape
    k = rms_norm(sk.reshape(B, L, SWA_KV_HEADS, SWA_HEAD_DIM), k_g)
    if rope is not None:
        k = apply_axial_rope(k, rope)
    return k, sv.reshape(B, L, SWA_KV_HEADS, SWA_HEAD_DIM)


def sink_column(sink, s):
    return jnp.broadcast_to(sink.astype(jnp.float32)[None, :, :, None, None], s.shape[:-1] + (1,))


def window_attention(q, k, v, k_ctx, v_ctx, sink):
    B, L, KV, G, d = q.shape
    nb = L // BLOCK
    span = BLOCK + 2 * WINDOW
    n_ctx = k_ctx.shape[1]
    scale = d ** -0.5
    pad = ((0, 0), (WINDOW, WINDOW), (0, 0), (0, 0))
    kp, vp = jnp.pad(k, pad), jnp.pad(v, pad)
    qb = q.reshape(B, nb, BLOCK, KV, G, d).transpose(1, 0, 2, 3, 4, 5)
    qi = jnp.arange(BLOCK)[:, None]
    kj = jnp.arange(span)[None, :]
    band = (kj >= qi) & (kj <= qi + 2 * WINDOW)

    def one_block(args):
        b, q_blk = args
        start = b * BLOCK
        k_win = lax.dynamic_slice_in_dim(kp, start, span, axis=1)
        v_win = lax.dynamic_slice_in_dim(vp, start, span, axis=1)
        j = start - WINDOW + kj
        mask = band & (j >= 0) & (j < L)
        s_win = jnp.einsum('bqkgd,bskd->bkgqs', q_blk, k_win).astype(jnp.float32) * scale
        s_win = jnp.where(mask, s_win, NEG_INF)
        s_ctx = jnp.einsum('bqkgd,bckd->bkgqc', q_blk, k_ctx).astype(jnp.float32) * scale
        s = jnp.concatenate([s_win, s_ctx, sink_column(sink, s_win)], axis=-1)
        p = jax.nn.softmax(s, axis=-1).astype(v.dtype)
        return (jnp.einsum('bkgqs,bskd->bqkgd', p[..., :span], v_win)
                + jnp.einsum('bkgqc,bckd->bqkgd', p[..., span:span + n_ctx], v_ctx))

    o = lax.map(one_block, (jnp.arange(nb), qb))
    return o.transpose(1, 0, 2, 3, 4, 5).reshape(B, L, KV * G * d)


def context_attention(q, k, v, sink):
    B, L, KV, G, d = q.shape
    s = jnp.einsum('bqkgd,bckd->bkgqc', q, k).astype(jnp.float32) * d ** -0.5
    p = jax.nn.softmax(jnp.concatenate([s, sink_column(sink, s)], axis=-1), axis=-1)[..., :-1].astype(v.dtype)
    return jnp.einsum('bkgqc,bckd->bqkgd', p, v).reshape(B, L, KV * G * d)


def merge_groups(o_a, o_b, o_c, g, w_out):
    B, L, _ = o_a.shape
    o = jnp.concatenate([o_a, o_b, o_c], axis=-1).reshape(B, L, 3, GROUP_WIDTH)
    return rms_norm(o, g.reshape(3, GROUP_WIDTH)).reshape(B, L, MIX_WIDTH) @ w_out


def sq_relu_mlp(h, w1, w2):
    return jnp.square(jax.nn.relu(h @ w1)) @ w2


def token_mixers(h, hc, w_in, q_a_g, w_uq, kv_a_g, w_ukv, mla_q_g, mla_k_g, conv_w, conv_b,
                 lru_gate_w, lru_gate_b, lru_lambda, swa_q_g, swa_k_g, swa_sink, group_g, w_out,
                 rope_mla, rope_swa, with_ctx_out):
    B = h.shape[0]
    cq, ckv, kr, lx, lg, sq, sk, sv = split_columns(h @ w_in)
    c_cq, c_ckv, c_kr, c_lx, c_lg, c_sq, c_sk, c_sv = split_columns(hc @ w_in)

    k_a, v_a = mla_key_value(ckv, kr, kv_a_g, w_ukv, mla_k_g, rope_mla)
    kc_a, vc_a = mla_key_value(c_ckv, c_kr, kv_a_g, w_ukv, mla_k_g, None)
    o_a = dense_block_attention(mla_query(cq, q_a_g, w_uq, mla_q_g, rope_mla),
                                jnp.concatenate([kc_a, k_a], axis=1), jnp.concatenate([vc_a, v_a], axis=1))

    a, u = rglru_coefficients(centred_depthwise_conv(lx, conv_w, conv_b), lru_gate_w, lru_gate_b, lru_lambda)
    ac, uc = rglru_coefficients(centred_depthwise_conv(c_lx, conv_w, conv_b), lru_gate_w, lru_gate_b, lru_lambda)
    zero = jnp.zeros((B, LRU_WIDTH), jnp.float32)
    hc_f = linear_scan(ac[0], uc[0], zero, False)
    hc_b = linear_scan(ac[1], uc[1], zero, True)
    h_f = linear_scan(a[0], u[0], hc_f[:, -1], False)
    h_b = linear_scan(a[1], u[1], hc_b[:, 0], True)
    o_b = (h_f + h_b).astype(h.dtype) * jax.nn.gelu(lg)

    sink = swa_sink.reshape(SWA_KV_HEADS, SWA_GROUP)
    k_c, v_c = swa_key_value(sk, sv, swa_k_g, rope_swa)
    kc_c, vc_c = swa_key_value(c_sk, c_sv, swa_k_g, None)
    o_c = window_attention(swa_query(sq, swa_q_g, rope_swa), k_c, v_c, kc_c, vc_c, sink)

    y = merge_groups(o_a, o_b, o_c, group_g, w_out)
    if not with_ctx_out:
        return y, None
    oc_a = dense_block_attention(mla_query(c_cq, q_a_g, w_uq, mla_q_g, None), kc_a, vc_a)
    oc_b = (hc_f + hc_b).astype(hc.dtype) * jax.nn.gelu(c_lg)
    oc_c = context_attention(swa_query(c_sq, swa_q_g, None), kc_c, vc_c, sink)
    return y, merge_groups(oc_a, oc_b, oc_c, group_g, w_out)


def setup_inputs(seed: int = 0) -> dict:
    key = jax.random.key(seed)
    ks = jax.random.split(key, 32)

    def nrm(k, shape, fan_in, gain=1.0):
        return gain * fan_in ** -0.5 * jax.random.normal(k, shape, jnp.float32)

    def gains(k, shape):
        return 1.0 + 0.05 * jax.random.normal(k, shape, jnp.float32)

    u = jax.random.uniform(ks[18], (DEPTH, 2, LRU_WIDTH), jnp.float32, minval=0.9, maxval=0.999)
    a_base = u ** (1.0 / LRU_C)
    return {
        'x': jax.random.normal(ks[0], (BATCH, SEQ, D_MODEL), jnp.float32),
        'c': jax.random.normal(ks[1], (BATCH, D_MODEL), jnp.float32),
        'ctx': jax.random.normal(ks[2], (BATCH, CTX_LEN, D_MODEL), jnp.float32),
        'c_ctx': jax.random.normal(ks[3], (D_MODEL,), jnp.float32),
        'w_mod': nrm(ks[4], (DEPTH, D_MODEL, N_MOD * D_MODEL), D_MODEL, 0.5),
        'b_mod': 0.02 * jax.random.normal(ks[5], (DEPTH, N_MOD * D_MODEL), jnp.float32),
        'norm1_g': gains(ks[6], (DEPTH, D_MODEL)),
        'w_in': nrm(ks[7], (DEPTH, D_MODEL, IN_WIDTH), D_MODEL),
        'q_a_g': gains(ks[8], (DEPTH, MLA_Q_RANK)),
        'w_uq': nrm(ks[9], (DEPTH, MLA_Q_RANK, MLA_HEADS * MLA_QK), MLA_Q_RANK),
        'kv_a_g': gains(ks[10], (DEPTH, MLA_KV_RANK)),
        'w_ukv': nrm(ks[11], (DEPTH, MLA_KV_RANK, MLA_HEADS * (MLA_NOPE + MLA_V)), MLA_KV_RANK),
        'mla_q_g': gains(ks[12], (DEPTH, MLA_QK)),
        'mla_k_g': gains(ks[13], (DEPTH, MLA_QK)),
        'conv_w': nrm(ks[14], (DEPTH, CONV_W, LRU_WIDTH), CONV_W),
        'conv_b': 0.02 * jax.random.normal(ks[15], (DEPTH, LRU_WIDTH), jnp.float32),
        'lru_gate_w': nrm(ks[16], (DEPTH, 2, 2, LRU_BLOCKS, LRU_BLOCK_DIM, LRU_BLOCK_DIM), LRU_BLOCK_DIM),
        'lru_gate_b': 0.02 * jax.random.normal(ks[17], (DEPTH, 2, 2, LRU_WIDTH), jnp.float32),
        'lru_lambda': jnp.log(a_base) - jnp.log1p(-a_base),
        'swa_q_g': gains(ks[19], (DEPTH, SWA_HEAD_DIM)),
        'swa_k_g': gains(ks[20], (DEPTH, SWA_HEAD_DIM)),
        'swa_sink': jax.random.normal(ks[21], (DEPTH, SWA_HEADS), jnp.float32),
        'group_g': gains(ks[22], (DEPTH, MIX_WIDTH)),
        'w_out': nrm(ks[23], (DEPTH, MIX_WIDTH, D_MODEL), MIX_WIDTH),
        'norm2_g': gains(ks[24], (DEPTH, D_MODEL)),
        'w_ff1': nrm(ks[25], (DEPTH, D_MODEL, D_FF), D_MODEL),
        'w_ff2': nrm(ks[26], (DEPTH, D_FF, D_MODEL), D_FF),
    }


def reference(x, c, ctx, c_ctx, w_mod, b_mod, norm1_g, w_in, q_a_g, w_uq, kv_a_g, w_ukv, mla_q_g, mla_k_g,
              conv_w, conv_b, lru_gate_w, lru_gate_b, lru_lambda, swa_q_g, swa_k_g, swa_sink, group_g, w_out,
              norm2_g, w_ff1, w_ff2):
    rows = x.shape[1] // GRID_W
    rope_mla = axial_rope_tables(rows, MLA_ROPE)
    rope_swa = axial_rope_tables(rows, SWA_HEAD_DIM)
    act_c = jax.nn.silu(c)
    act_cc = jax.nn.silu(c_ctx)
    xc = ctx
    for layer in range(DEPTH):
        last = layer == DEPTH - 1
        sh1, sc1, g1, sh2, sc2, g2 = jnp.split((act_c @ w_mod[layer] + b_mod[layer])[:, None, :], N_MOD, axis=-1)
        csh1, csc1, cg1, csh2, csc2, cg2 = jnp.split(act_cc @ w_mod[layer] + b_mod[layer], N_MOD, axis=-1)
        y, yc = token_mixers(modulate(x, norm1_g[layer], sh1, sc1), modulate(xc, norm1_g[layer], csh1, csc1),
                             w_in[layer], q_a_g[layer], w_uq[layer], kv_a_g[layer], w_ukv[layer],
                             mla_q_g[layer], mla_k_g[layer], conv_w[layer], conv_b[layer],
                             lru_gate_w[layer], lru_gate_b[layer], lru_lambda[layer],
                             swa_q_g[layer], swa_k_g[layer], swa_sink[layer], group_g[layer], w_out[layer],
                             rope_mla, rope_swa, not last)
        x = x + g1 * y
        x = x + g2 * sq_relu_mlp(modulate(x, norm2_g[layer], sh2, sc2), w_ff1[layer], w_ff2[layer])
        if not last:
            xc = xc + cg1 * yc
            xc = xc + cg2 * sq_relu_mlp(modulate(xc, norm2_g[layer], csh2, csc2), w_ff1[layer], w_ff2[layer])
    return x
```

```cpp
#include <hip/hip_runtime.h>
#include <hip/hip_cooperative_groups.h>
#include <cstdio>
#include <cstdint>
namespace cg = cooperative_groups;
namespace pg8 {
#define PG8_LAS __attribute__((address_space(3)))
typedef unsigned short bf16_t;
typedef short bf16x8 __attribute__((ext_vector_type(8)));
typedef float f32x4 __attribute__((ext_vector_type(4)));
typedef unsigned u32x4 __attribute__((ext_vector_type(4)));
constexpr int BM = 256, BK = 64, HALF = 128, HTB = HALF * BK * 2  , STAGE_BYTES = 8 * HTB, NXCD = 8, WGM = 8;

__host__ __device__ __forceinline__ int lds_byte(int r, int c) { const int st = (r >> 4) * 2 + (c >> 5), rr = r & 15, cc = c & 31, ob = rr * 64 + cc * 2; return st * 1024 + (ob ^ (((ob >> 9) & 1) << 5)); }
__host__ __device__ __forceinline__ void stage_rc(int b, int& R, int& C) { const int st = b / 1024, sb = b % 1024, swz = sb ^ (((sb >> 9) & 1) << 5); R = (st >> 1) * 16 + swz / 64; C = (st & 1) * 32 + (swz % 64) / 2; }
__host__ __device__ __forceinline__ int perm32(int rho) { const int n = rho >> 4, i = rho & 15; return 8 * (i >> 2) + 4 * n + (i & 3); }

struct Unit { int pm, pn; };
struct Gemm { const bf16_t* A; const bf16_t* Bt; int M, N, K, lda; };

struct StaticOrder {
    int nM, nN, nwg, G, c;
    __host__ __device__ void init(int M, int N, int G_, int c_) { nM = M / BM; nN = N / BM; nwg = nM * nN; G = G_; c = c_; }
    __host__ __device__ bool next(int i, Unit& u) const {
        const long L = (long)i * G + c; if (L >= nwg) return false;
        int wgid = (int)L; { const int q = nwg / NXCD, r = nwg % NXCD, xcd = wgid % NXCD, off = wgid / NXCD; wgid = (xcd < r ? xcd * (q + 1) : r * (q + 1) + (xcd - r) * q) + off; }
        const int nig = WGM * nN, gid = wgid / nig, fm = gid * WGM, gsz = (nM - fm) < WGM ? (nM - fm) : WGM;
        u.pm = fm + ((wgid % nig) % gsz); u.pn = (wgid % nig) / gsz; return true;
    }
    __device__ __forceinline__ void a_ready(const Unit&) const {}
    __device__ __forceinline__ void done(const Unit&) const {}
};

__device__ __forceinline__ unsigned cvt_pk_bf16(float lo, float hi) { unsigned r; asm volatile("v_cvt_pk_bf16_f32 %0, %1, %2" : "=v"(r) : "v"(lo), "v"(hi)); return r; }
typedef float f32x2 __attribute__((ext_vector_type(2)));
template <class Epi, class Sched, bool ALIGN_EPI = false, bool SP2 = false>
__device__ __forceinline__ void gemm_phase(PG8_LAS unsigned char* lds, const Gemm g, const Sched& S, const Epi& E, const int WB) {
    int tid_l = WB + (int)__builtin_amdgcn_mbcnt_hi(~0u, __builtin_amdgcn_mbcnt_lo(~0u, 0u)); asm volatile("" : "+v"(tid_l)); const int tid = tid_l, wid = __builtin_amdgcn_readfirstlane(tid >> 6), lane = tid & 63, wr = wid >> 2, wc = wid & 3, fr = lane & 15, fq = lane >> 4;
    const int K = g.K, nt = K / BK;
    unsigned voffA[2], voffB[2];
#pragma unroll
    for (int i = 0; i < 2; ++i) { int R, C; stage_rc(tid * 16 + i * 8192, R, C); const int Rb = Epi::PERM ? ((R & ~31) + perm32(R & 31)) : R;
        voffA[i] = (unsigned)(R * g.lda + C) * 2u; voffB[i] = (unsigned)(Rb * K + C) * 2u; }
    const size_t kstep = (size_t)(BK * 2);
    const size_t hstepA = (size_t)HALF * g.lda * 2, hstepB = (size_t)HALF * K * 2;
    const size_t tstepA = 2 * hstepA, tstepB = 2 * hstepB;
    const unsigned ldsw = (unsigned)wid * 1024u;
    const int aoff = lds_byte(wr * 64 + fr, fq * 8), boff = lds_byte(wc * 32 + fr, fq * 8);
#define PG8_SA(b, h) (((b) * 2 + (h)) * HTB)
#define PG8_SB(b, h) ((4 + (b) * 2 + (h)) * HTB)
#define PG8_STAGE(bufoff, gbase, voff) do { _Pragma("unroll") for (int _i = 0; _i < 2; ++_i) \
        __builtin_amdgcn_global_load_lds((const unsigned*)((const char*)(gbase) + (voff)[_i]), (PG8_LAS unsigned*)(lds + (bufoff) + ldsw + _i * 8192), 16, 0, 0); } while (0)
#define PG8_LDA(dst, b, h) do { _Pragma("unroll") for (int m = 0; m < 4; ++m) _Pragma("unroll") for (int k = 0; k < 2; ++k) dst[m][k] = *(const PG8_LAS bf16x8*)(lds + PG8_SA(b, h) + aoff + m * 2048 + k * 1024); } while (0)
#define PG8_LDB(dst, b, h) do { _Pragma("unroll") for (int n = 0; n < 2; ++n) _Pragma("unroll") for (int k = 0; k < 2; ++k) dst[n][k] = *(const PG8_LAS bf16x8*)(lds + PG8_SB(b, h) + boff + n * 2048 + k * 1024); } while (0)
#define PG8_MMA(ai, bj, At, Bt) do { __builtin_amdgcn_s_setprio(1); _Pragma("unroll") for (int m = 0; m < 4; ++m) _Pragma("unroll") for (int n = 0; n < 2; ++n) _Pragma("unroll") for (int k = 0; k < 2; ++k) \
        acc[ai][bj][m][n] = __builtin_amdgcn_mfma_f32_16x16x32_bf16(Bt[n][k], At[m][k], acc[ai][bj][m][n], 0, 0, 0); __builtin_amdgcn_s_setprio(0); } while (0)
#define PG8_WAIT_V(n) asm volatile("s_waitcnt vmcnt(" #n ")" ::: "memory")
#define PG8_WAIT_L(n) asm volatile("s_waitcnt lgkmcnt(" #n ")" ::: "memory")
#define PG8_BAR __builtin_amdgcn_s_barrier()
#define PG8_SCHED __builtin_amdgcn_sched_barrier(0)
    Unit cur, nxt; int ui = 0;
    if (!S.next(0, cur)) return;
    f32x4 acc[2][2][4][2];
#pragma unroll
    for (int a = 0; a < 2; ++a)
#pragma unroll
        for (int b = 0; b < 2; ++b)
#pragma unroll
            for (int m = 0; m < 4; ++m)
#pragma unroll
                for (int n = 0; n < 2; ++n) acc[a][b][m][n] = (f32x4){0.f, 0.f, 0.f, 0.f};
    bf16x8 At[4][2], B0[2][2], B1[2][2];
    const char* cA = (const char*)g.A + (size_t)cur.pm * tstepA; const char* cB = (const char*)g.Bt + (size_t)cur.pn * tstepB;
    S.a_ready(cur);
    if constexpr (SP2) {
        PG8_STAGE(PG8_SB(0, 0), cB, voffB); PG8_STAGE(PG8_SB(0, 1), cB + hstepB, voffB); PG8_STAGE(PG8_SA(0, 0), cA, voffA); PG8_STAGE(PG8_SA(0, 1), cA + hstepA, voffA);
        if (wr == 1) PG8_BAR;
        PG8_WAIT_V(2); PG8_BAR;
        PG8_STAGE(PG8_SB(1, 0), cB + kstep, voffB); PG8_STAGE(PG8_SA(1, 0), cA + kstep, voffA); PG8_STAGE(PG8_SB(1, 1), cB + hstepB + kstep, voffB);
        PG8_WAIT_V(6); PG8_BAR;
    } else {
        PG8_STAGE(PG8_SB(0, 0), cB, voffB); PG8_STAGE(PG8_SA(0, 0), cA, voffA); PG8_STAGE(PG8_SB(0, 1), cB + hstepB, voffB); PG8_STAGE(PG8_SA(0, 1), cA + hstepA, voffA);
        if (wr == 1) PG8_BAR;
        PG8_WAIT_V(4); PG8_BAR;
        PG8_STAGE(PG8_SB(1, 0), cB + kstep, voffB); PG8_STAGE(PG8_SA(1, 0), cA + kstep, voffA); PG8_STAGE(PG8_SB(1, 1), cB + hstepB + kstep, voffB);
        PG8_WAIT_V(6); PG8_BAR;
    }
    for (;;) {
        const bool has_next = S.next(ui + 1, nxt);
        const char* nA = has_next ? (const char*)g.A + (size_t)nxt.pm * tstepA : cA; const char* nB = has_next ? (const char*)g.Bt + (size_t)nxt.pn * tstepB : cB;
        for (int t = 0; t < nt; t += 2) {
            const bool last = (t == nt - 2);
            const char* a1 = cA + (size_t)(t + 1) * kstep;
            const char* a2 = last ? nA : cA + (size_t)(t + 2) * kstep; const char* b2 = last ? nB : cB + (size_t)(t + 2) * kstep;
            const char* a3 = a2 + kstep; const char* b3 = b2 + kstep;
            if (last && has_next) S.a_ready(nxt);
            if constexpr (SP2) {
            PG8_LDB(B0, 0, 0); PG8_LDB(B1, 0, 1); PG8_SCHED; PG8_LDA(At, 0, 0); PG8_STAGE(PG8_SA(1, 1), a1 + hstepA, voffA);
            PG8_WAIT_V(8); PG8_WAIT_L(0); PG8_BAR; PG8_MMA(0, 0, At, B0); PG8_MMA(0, 1, At, B1); PG8_BAR; PG8_SCHED;
            PG8_LDA(At, 0, 1); PG8_STAGE(PG8_SB(0, 0), b2, voffB); PG8_STAGE(PG8_SB(0, 1), b2 + hstepB, voffB); PG8_STAGE(PG8_SA(0, 0), a2, voffA);
            PG8_WAIT_V(8); PG8_WAIT_L(0); PG8_BAR; PG8_MMA(1, 0, At, B0); PG8_MMA(1, 1, At, B1); PG8_BAR; PG8_SCHED;
            PG8_LDB(B0, 1, 0); PG8_LDB(B1, 1, 1); PG8_SCHED; PG8_LDA(At, 1, 0); PG8_STAGE(PG8_SA(0, 1), a2 + hstepA, voffA);
            PG8_WAIT_V(8); PG8_WAIT_L(0); PG8_BAR; PG8_MMA(0, 0, At, B0); PG8_MMA(0, 1, At, B1); PG8_BAR; PG8_SCHED;
            PG8_LDA(At, 1, 1); PG8_STAGE(PG8_SB(1, 0), b3, voffB); PG8_STAGE(PG8_SB(1, 1), b3 + hstepB, voffB); PG8_STAGE(PG8_SA(1, 0), a3, voffA);
            PG8_WAIT_V(8); PG8_WAIT_L(0); PG8_BAR; PG8_MMA(1, 0, At, B0); PG8_MMA(1, 1, At, B1); PG8_BAR; PG8_SCHED;
            } else {
            PG8_LDB(B0, 0, 0); PG8_SCHED; PG8_LDA(At, 0, 0); PG8_STAGE(PG8_SA(1, 1), a1 + hstepA, voffA);
            PG8_WAIT_L(8); PG8_BAR; PG8_WAIT_L(0); PG8_MMA(0, 0, At, B0); PG8_BAR; PG8_SCHED;
            PG8_LDB(B1, 0, 1); PG8_STAGE(PG8_SB(0, 0), b2, voffB);
            PG8_BAR; PG8_WAIT_L(0); PG8_MMA(0, 1, At, B1); PG8_BAR;
            PG8_LDA(At, 0, 1); PG8_STAGE(PG8_SA(0, 0), a2, voffA);
            PG8_BAR; PG8_WAIT_L(0); PG8_MMA(1, 0, At, B0); PG8_BAR; PG8_SCHED;
            PG8_STAGE(PG8_SB(0, 1), b2 + hstepB, voffB);
            PG8_WAIT_V(6); PG8_BAR; PG8_MMA(1, 1, At, B1); PG8_BAR;
            PG8_LDB(B0, 1, 0); PG8_SCHED; PG8_LDA(At, 1, 0); PG8_STAGE(PG8_SA(0, 1), a2 + hstepA, voffA);
            PG8_WAIT_L(8); PG8_BAR; PG8_WAIT_L(0); PG8_MMA(0, 0, At, B0); PG8_BAR; PG8_SCHED;
            PG8_LDB(B1, 1, 1); PG8_STAGE(PG8_SB(1, 0), b3, voffB);
            PG8_BAR; PG8_WAIT_L(0); PG8_MMA(0, 1, At, B1); PG8_BAR;
            PG8_LDA(At, 1, 1); PG8_STAGE(PG8_SA(1, 0), a3, voffA);
            PG8_BAR; PG8_WAIT_L(0); PG8_MMA(1, 0, At, B0); PG8_BAR; PG8_SCHED;
            PG8_STAGE(PG8_SB(1, 1), b3 + hstepB, voffB);
            PG8_WAIT_V(6); PG8_BAR; PG8_MMA(1, 1, At, B1); PG8_BAR;
            }
        }
        if constexpr (ALIGN_EPI) { if (wr == 0) PG8_BAR; }
        if constexpr (!Epi::AFTER_DRAIN) { E(acc, cur, wr, wc, fr, fq); S.done(cur); }
        if (!has_next) break;
#pragma unroll
        for (int a = 0; a < 2; ++a)
#pragma unroll
            for (int b = 0; b < 2; ++b)
#pragma unroll
                for (int m = 0; m < 4; ++m)
#pragma unroll
                    for (int n = 0; n < 2; ++n) acc[a][b][m][n] = (f32x4){0.f, 0.f, 0.f, 0.f};
        cur = nxt; cA = nA; cB = nB; ++ui;
        if constexpr (ALIGN_EPI) { if (wr == 1) PG8_BAR; }
    }
    PG8_WAIT_V(0);
    if constexpr (!ALIGN_EPI) { if (wr == 0) PG8_BAR; }
    PG8_BAR;
    if constexpr (Epi::AFTER_DRAIN) { E.fused(acc, cur, wr, wc, fr, fq, lds, wid, lane); S.done(cur); }
#undef PG8_SA
#undef PG8_SB
#undef PG8_STAGE
#undef PG8_LDA
#undef PG8_LDB
#undef PG8_MMA
#undef PG8_WAIT_V
#undef PG8_WAIT_L
#undef PG8_BAR
#undef PG8_SCHED
}
}
namespace pg8 {
typedef unsigned u32x2v __attribute__((ext_vector_type(2)));
template <int ACT> struct EpiStore {
    static constexpr bool PERM = true, AFTER_DRAIN = false;
    bf16_t* O; int ldc;
    __device__ __forceinline__ void operator()(const f32x4 (&acc)[2][2][4][2], const Unit& u, int wr, int wc, int fr, int fq) const {
        const int row0 = u.pm * BM + wr * 64 + fr; const int col0 = u.pn * BM + wc * 32 + 8 * fq;
#pragma unroll
        for (int ai = 0; ai < 2; ++ai)
#pragma unroll
            for (int m = 0; m < 4; ++m) { bf16_t* rowp = O + (size_t)(row0 + ai * HALF + m * 16) * ldc + col0;
#pragma unroll
                for (int bj = 0; bj < 2; ++bj) { f32x4 v0 = acc[ai][bj][m][0], v1 = acc[ai][bj][m][1];
                    if (ACT == 2) {
#pragma unroll
                        for (int e = 0; e < 4; ++e) { float a = fmaxf(v0[e], 0.f), b = fmaxf(v1[e], 0.f); v0[e] = a * a; v1[e] = b * b; } }
                    u32x4 w; w.x = cvt_pk_bf16(v0[0], v0[1]); w.y = cvt_pk_bf16(v0[2], v0[3]); w.z = cvt_pk_bf16(v1[0], v1[1]); w.w = cvt_pk_bf16(v1[2], v1[3]);
                    *(u32x4*)(rowp + bj * HALF) = w; } }
    }
};
struct EpiResid {
    static constexpr bool PERM = false, AFTER_DRAIN = false;
    const float* res_lat; const float* res_ctx; float* out_lat; float* out_ctx; const float* gate;
    __device__ __forceinline__ void operator()(const f32x4 (&acc)[2][2][4][2], const Unit& u, int wr, int wc, int fr, int fq) const {
        const bool lat = u.pm < 128; const int mr = lat ? (u.pm >> 3) : 16;
        const float* rb = lat ? res_lat + (size_t)u.pm * BM * 1024 : res_ctx + (size_t)(u.pm - 128) * BM * 1024;
        float* ob = lat ? out_lat + (size_t)u.pm * BM * 1024 : out_ctx + (size_t)(u.pm - 128) * BM * 1024;
        const float* gp = gate + (size_t)mr * 6144;
#pragma unroll
        for (int bj = 0; bj < 2; ++bj)
#pragma unroll
            for (int n = 0; n < 2; ++n) { const int col = u.pn * BM + bj * HALF + wc * 32 + n * 16 + 4 * fq; const f32x4 g = *(const f32x4*)(gp + col);
#pragma unroll
                for (int ai = 0; ai < 2; ++ai)
#pragma unroll
                    for (int m = 0; m < 4; ++m) { const size_t off = (size_t)(ai * HALF + wr * 64 + m * 16 + fr) * 1024 + col;
                        const f32x4 r = *(const f32x4*)(rb + off); *(f32x4*)(ob + off) = r + g * acc[ai][bj][m][n]; } }
    }
};
struct EpiGate {
    static constexpr bool PERM = false, AFTER_DRAIN = false;
    const bf16_t* XC; unsigned* AU; const float* gb; const float* lam; int j; int ntok;
    __device__ __forceinline__ void operator()(const f32x4 (&acc)[2][2][4][2], const Unit& u, int wr, int wc, int fr, int fq) const {
#pragma unroll
        for (int bj = 0; bj < 2; ++bj)
#pragma unroll
            for (int n = 0; n < 2; ++n) { const int colb = u.pn * BM + bj * HALF + wc * 32 + n * 16 + 4 * fq; const int ch = 128 * j + (colb >> 2);
                const float brf = gb[ch], bif = gb[512 + ch], brb = gb[1024 + ch], bib = gb[1536 + ch];
                const float lf = lam[ch], lb = lam[512 + ch];
                const float spf = __logf(1.f + __expf(-lf)) * (-8.f * 1.4426950408889634f), spb = __logf(1.f + __expf(-lb)) * (-8.f * 1.4426950408889634f);
#pragma unroll
                for (int ai = 0; ai < 2; ++ai)
#pragma unroll
                    for (int m = 0; m < 4; ++m) { const int row = u.pm * BM + ai * HALF + wr * 64 + m * 16 + fr;
                        const unsigned o = (unsigned)row * 512u + (unsigned)ch; const float x = __uint_as_float((unsigned)XC[o] << 16);
                        const f32x4 v = acc[ai][bj][m][n];
                        const float rf = 1.f / (1.f + __expf(-(v[0] + brf))), jf = 1.f / (1.f + __expf(-(v[1] + bif)));
                        const float rb = 1.f / (1.f + __expf(-(v[2] + brb))), jb = 1.f / (1.f + __expf(-(v[3] + bib)));
                        const float laf = rf * spf, lab = rb * spb;
                        const float uf = sqrtf(fmaxf(1.f - __builtin_amdgcn_exp2f(2.f * laf), 0.f)) * jf * x;
                        const float ub = sqrtf(fmaxf(1.f - __builtin_amdgcn_exp2f(2.f * lab), 0.f)) * jb * x;
                        AU[o] = cvt_pk_bf16(laf, uf);
                        AU[o + (unsigned)ntok * 512u] = cvt_pk_bf16(lab, ub); } }
    }
};
}
#define DI __device__ __forceinline__
#define LAS __attribute__((address_space(3)))
typedef unsigned short bf16_t;
typedef float f32x4 __attribute__((ext_vector_type(4)));
typedef float f32x2 __attribute__((ext_vector_type(2)));
typedef float f32x16 __attribute__((ext_vector_type(16)));
typedef short bf16x8 __attribute__((ext_vector_type(8)));
typedef short s16x4 __attribute__((ext_vector_type(4)));
typedef unsigned u32x4 __attribute__((ext_vector_type(4)));
typedef unsigned u32x2 __attribute__((ext_vector_type(2)));
typedef __bf16 bf16x2_t __attribute__((ext_vector_type(2)));

constexpr int NB = 16, LSEQ = 2048, NC = 256, DM = 1024, NLAT = NB * LSEQ, NCTX = NB * NC, NTOK = NLAT + NCTX;
constexpr int PW = 2304;
constexpr int C_CQ = 0, C_CKV = 256, C_KR = 384, C_LX = 416, C_LG = 928, C_SQ = 1440, C_SK = 1952, C_SV = 2080;
constexpr float EPS = 1e-6f, LOG2E = 1.4426950408889634f, LOG2_THETA = 13.287712379549449f;
constexpr int NTHR = 512, NWAVE = 8;
constexpr int LDS_BYTES = 147456;

constexpr size_t MiB = 1u << 20;
constexpr size_t WS_MOD = 1 * MiB;
constexpr size_t WS_W = 2 * MiB;
constexpr size_t W_IN = 0, W_UQ = W_IN + (size_t)2304 * 1024 * 2, W_UKV = W_UQ + (size_t)768 * 256 * 2, W_G = W_UKV + (size_t)1280 * 128 * 2,
                 W_OUT = W_G + (size_t)4 * 512 * 128 * 2, W_FF1 = W_OUT + (size_t)1024 * 1536 * 2, W_FF2 = W_FF1 + (size_t)4096 * 1024 * 2, W_END = W_FF2 + (size_t)1024 * 4096 * 2;
static_assert(W_END <= 25 * MiB, "weights");
constexpr size_t WS_XCRES = 27 * MiB;
constexpr size_t WS_R1 = 43 * MiB;
constexpr size_t WS_HN = WS_R1, WS_SK = WS_R1, WS_CKVN = WS_R1 + 9 * MiB, WS_CQN = WS_R1 + 18 * MiB, WS_XC = WS_R1 + 36 * MiB;
constexpr size_t WS_KVR = 115 * MiB;
constexpr size_t WS_ON = WS_R1;
constexpr size_t WS_P = 205 * MiB;
constexpr size_t WS_AU = WS_P;
constexpr size_t WS_QR = 367 * MiB;
constexpr size_t WS_SQ = 421 * MiB;
constexpr size_t WS_LG = 457 * MiB;
constexpr size_t WS_SV = 493 * MiB;
constexpr size_t WS_KR = 502 * MiB;
constexpr size_t WS_H = 115 * MiB;
constexpr size_t WS_END = 512 * MiB;
static_assert(WS_H + (size_t)NTOK * 4096 * 2 <= WS_LG, "H overlay");

DI int tid_from(int WB) { int t = WB + (int)__builtin_amdgcn_mbcnt_hi(~0u, __builtin_amdgcn_mbcnt_lo(~0u, 0u)); asm volatile("" : "+v"(t)); return t; }
#define my_tid() tid_from(WB)
DI float bf2f(bf16_t v) { return __uint_as_float((unsigned)v << 16); }
DI float bflo(unsigned w) { return __uint_as_float(w << 16); }
DI float bfhi(unsigned w) { return __uint_as_float(w & 0xffff0000u); }
DI unsigned cvtpk(float lo, float hi) { f32x2 v = {lo, hi}; bf16x2_t b = __builtin_convertvector(v, bf16x2_t); return __builtin_bit_cast(unsigned, b); }
DI float shx(float v, int o, int lane) { return __int_as_float(__builtin_amdgcn_ds_bpermute((lane ^ o) << 2, __float_as_int(v))); }
#define SHX(v, o) shx((v), (o), lane)
DI float wave_sum_(float v, int lane) {
#pragma unroll
    for (int o = 1; o < 64; o <<= 1) v += SHX(v, o);
    return v;
}
#define wave_sum(v) wave_sum_((v), lane)
DI float sigmoidf_(float x) { return 1.f / (1.f + __expf(-x)); }

DI void phase_mod(const float* c, const float* cctx, const float* w_mod, const float* b_mod, float* MOD, LAS unsigned char* L, const int WB) {
    LAS float* act = (LAS float*)L;
    LAS float* red = (LAS float*)(L + 17 * 1024 * 4);
    const int tid = my_tid(), lane = tid & 63, wave = WB >> 6;
    for (int i = tid; i < 17 * 1024; i += NTHR) { const int r = i >> 10, k = i & 1023; const float v = r < 16 ? c[r * 1024 + k] : cctx[k]; act[i] = v / (1.f + __expf(-v)); }
    __syncthreads();
    for (int item = blockIdx.x; item < 2 * 96; item += gridDim.x) {
        const int l = item / 96, cgp = item % 96, col = cgp * 64 + lane;
        const float* w = w_mod + (size_t)l * 1024 * 6144 + col;
        float acc[17];
#pragma unroll
        for (int r = 0; r < 17; ++r) acc[r] = 0.f;
#pragma unroll 4
        for (int k = wave * 128; k < wave * 128 + 128; ++k) { const float wv = w[(size_t)k * 6144];
#pragma unroll
            for (int r = 0; r < 17; ++r) acc[r] += act[r * 1024 + k] * wv; }
#pragma unroll
        for (int r = 0; r < 17; ++r) red[(wave * 17 + r) * 64 + lane] = acc[r];
        __syncthreads();
        for (int i = tid; i < 17 * 64; i += NTHR) { const int r = i >> 6, cl = i & 63; float s = b_mod[l * 6144 + cgp * 64 + cl];
#pragma unroll
            for (int w8 = 0; w8 < 8; ++w8) s += red[(w8 * 17 + r) * 64 + cl];
            MOD[((size_t)l * 17 + r) * 6144 + cgp * 64 + cl] = s; }
        __syncthreads();
    }
}

DI void transpose_item(const float* W, int K, int N, bf16_t* WT, int k0, int n0, int dst_row0, LAS float* scr, int lane) {
#pragma unroll 8
    for (int i = 0; i < 32; ++i) { const int kk = 2 * i + (lane >> 5); scr[kk * 33 + (lane & 31)] = W[(size_t)(k0 + kk) * N + n0 + (lane & 31)]; }
    asm volatile("s_waitcnt lgkmcnt(0)" ::: "memory");
    const int c = lane & 7;
#pragma unroll
    for (int j = 0; j < 4; ++j) { const int n = (lane >> 3) + 8 * j; const LAS float* s = scr + (8 * c) * 33 + n;
        u32x4 o; o.x = cvtpk(s[0 * 33], s[1 * 33]); o.y = cvtpk(s[2 * 33], s[3 * 33]); o.z = cvtpk(s[4 * 33], s[5 * 33]); o.w = cvtpk(s[6 * 33], s[7 * 33]);
        *(u32x4*)(WT + (size_t)(dst_row0 + n) * K + k0 + 8 * c) = o; }
    asm volatile("s_waitcnt lgkmcnt(0)" ::: "memory");
}
struct LayerW { const float *w_in, *w_uq, *w_ukv, *gate_w, *w_out, *w_ff1, *w_ff2; };
DI void phase_convert(const LayerW& lw, unsigned char* wsw, LAS unsigned char* L, const int WB) {
    const int tid = my_tid(), lane = tid & 63, wave = WB >> 6;
    LAS float* scr = (LAS float*)(L + wave * 16384);
    const int gw = blockIdx.x * NWAVE + wave, NGW = gridDim.x * NWAVE;
    bf16_t* win_t = (bf16_t*)(wsw + W_IN); bf16_t* wuq_t = (bf16_t*)(wsw + W_UQ); bf16_t* wukv_t = (bf16_t*)(wsw + W_UKV); bf16_t* wg_t = (bf16_t*)(wsw + W_G);
    bf16_t* wout_t = (bf16_t*)(wsw + W_OUT); bf16_t* wff1_t = (bf16_t*)(wsw + W_FF1); bf16_t* wff2_t = (bf16_t*)(wsw + W_FF2);
    constexpr int I_IN = 16 * 69, I_UQ = 4 * 24, I_UKV = 2 * 32, I_OUT = 24 * 32, I_F1 = 16 * 128, I_F2 = 64 * 32;
    constexpr int NITEMS = I_IN + I_UQ + I_UKV + I_OUT + I_F1 + I_F2;
#pragma unroll 1
    for (int it = gw; it < NITEMS; it += NGW) {
        int r = it;
        if (r < I_IN) { const int kb = r / 69, nb = r % 69; transpose_item(lw.w_in, 1024, 2208, win_t, 64 * kb, 32 * nb, 32 * nb, scr, lane); continue; } r -= I_IN;
        if (r < I_UQ) { const int kb = r / 24, nb = r % 24; transpose_item(lw.w_uq, 256, 768, wuq_t, 64 * kb, 32 * nb, 32 * nb, scr, lane); continue; } r -= I_UQ;
        if (r < I_UKV) { const int kb = r / 32, nb = r % 32; const int hh = nb >> 2, jb = nb & 3; const int dr = hh * 160 + (jb < 2 ? jb * 32 : 96 + (jb - 2) * 32);
            transpose_item(lw.w_ukv, 128, 1024, wukv_t, 64 * kb, 32 * nb, dr, scr, lane); continue; } r -= I_UKV;
        if (r < I_OUT) { const int kb = r / 32, nb = r % 32; transpose_item(lw.w_out, 1536, 1024, wout_t, 64 * kb, 32 * nb, 32 * nb, scr, lane); continue; } r -= I_OUT;
        if (r < I_F1) { const int kb = r / 128, nb = r % 128; transpose_item(lw.w_ff1, 1024, 4096, wff1_t, 64 * kb, 32 * nb, 32 * nb, scr, lane); continue; } r -= I_F1;
        { const int kb = r / 32, nb = r % 32; transpose_item(lw.w_ff2, 4096, 1024, wff2_t, 64 * kb, 32 * nb, 32 * nb, scr, lane); }
    }
    const int gt = blockIdx.x * NTHR + tid; constexpr int NGT = 256 * NTHR;
#pragma unroll 1
    for (int i = gt; i < 96 * 1024 / 2; i += NGT) ((unsigned*)(win_t + (size_t)2208 * 1024))[i] = 0u;
#pragma unroll 1
    for (int i = gt; i < 8 * 32 * 128 / 2; i += NGT) { const int hh = i / (32 * 64), rem = i % (32 * 64); ((unsigned*)(wukv_t + (size_t)(hh * 160 + 64) * 128))[rem] = 0u; }
#pragma unroll 1
    for (int i = gt; i < 4 * 512 * 128; i += NGT) { const int k = i & 127, p = (i >> 7) & 511, j = i >> 16; const int cl = p >> 2, z = (p >> 1) & 1, g = p & 1;
        float v = 0.f; if ((k >> 6) == (cl >> 6)) { const int blk = 2 * j + (k >> 6); v = lw.gate_w[((((size_t)z * 2 + g) * 8 + blk) * 64 + (k & 63)) * 64 + (cl & 63)]; }
        wg_t[i] = (bf16_t)(cvtpk(v, 0.f) & 0xffffu); }
}

DI void norm_mod_row(const float* xrow, bf16_t* orow, const float* g, const float* shift, const float* scale, int lane) {
    f32x4 v[4]; float ss = 0.f;
#pragma unroll
    for (int j = 0; j < 4; ++j) { v[j] = *(const f32x4*)(xrow + 4 * lane + 256 * j); ss += (v[j].x * v[j].x + v[j].y * v[j].y) + (v[j].z * v[j].z + v[j].w * v[j].w); }
    const float rstd = rsqrtf(wave_sum(ss) * (1.f / 1024.f) + EPS);
#pragma unroll
    for (int j = 0; j < 4; ++j) { const int col = 4 * lane + 256 * j; const f32x4 gv = *(const f32x4*)(g + col), sh = *(const f32x4*)(shift + col), sc = *(const f32x4*)(scale + col);
        const f32x4 y = v[j] * rstd * gv * (sc + 1.f) + sh; u32x2 o; o.x = cvtpk(y.x, y.y); o.y = cvtpk(y.z, y.w); *(u32x2*)(orow + col) = o; }
}
DI void phase_norm(const float* xlat, const float* xctx, bf16_t* HN, const float* g, const float* modl, int chunk, int nrows, const int WB) {
    const int lane = my_tid() & 63, wave = WB >> 6;
    const int gw = blockIdx.x * NWAVE + wave, NGW = gridDim.x * NWAVE;
    for (int r = gw; r < nrows; r += NGW) {
        const bool lat = r < NLAT; const float* xr = lat ? xlat + (size_t)r * 1024 : xctx + (size_t)(r - NLAT) * 1024;
        const float* mp = modl + (size_t)(lat ? (r >> 11) : 16) * 6144 + chunk * 1024;
        norm_mod_row(xr, HN + (size_t)r * 1024, g, mp, mp + 1024, lane);
    }
}
DI void load8(const bf16_t* p, float (&v)[8]) { const u32x4 w = *(const u32x4*)p; v[0] = bflo(w.x); v[1] = bfhi(w.x); v[2] = bflo(w.y); v[3] = bfhi(w.y); v[4] = bflo(w.z); v[5] = bfhi(w.z); v[6] = bflo(w.w); v[7] = bfhi(w.w); }
DI void store8(bf16_t* p, const float (&v)[8]) { u32x4 w; w.x = cvtpk(v[0], v[1]); w.y = cvtpk(v[2], v[3]); w.z = cvtpk(v[4], v[5]); w.w = cvtpk(v[6], v[7]); *(u32x4*)p = w; }
DI void head64_norm_rope(float (&v)[8], const float* g, int lane, bool rope, int prow, int pcol, float outscale) {
    const int li = lane & 7;
    float ss = 0.f;
#pragma unroll
    for (int e = 0; e < 8; ++e) ss += v[e] * v[e];
    ss += SHX(ss, 1); ss += SHX(ss, 2); ss += SHX(ss, 4);
    const float rstd = rsqrtf(ss * (1.f / 64.f) + EPS);
    const int axis = li >> 2, half = (li >> 1) & 1; const float pos = (float)(axis ? pcol : prow);
#pragma unroll
    for (int e = 0; e < 8; ++e) v[e] = v[e] * rstd * g[8 * li + e];
#pragma unroll
    for (int e = 0; e < 8; ++e) { const float p = SHX(v[e], 2);
        if (rope) { const int i = 8 * (li & 1) + e; const float ang = pos * __builtin_amdgcn_exp2f(-(float)i * (LOG2_THETA / 16.f));
            const float cs = __cosf(ang), sn = __sinf(ang); const float rot = half ? p : -p; v[e] = v[e] * cs + rot * sn; } }
#pragma unroll
    for (int e = 0; e < 8; ++e) v[e] *= outscale;
}
struct PrepW { const float *q_a_g, *kv_a_g, *conv_w, *conv_b, *swa_q_g, *swa_k_g; };
DI void phase_prep(const bf16_t* P, const PrepW& w, bf16_t* CQN, bf16_t* CKVN, bf16_t* KR, bf16_t* XC, bf16_t* LG, bf16_t* SQ, bf16_t* SK, bf16_t* SV, const int WB) {
    const int lane = my_tid() & 63, wave = WB >> 6;
    const int gw = blockIdx.x * NWAVE + wave, NGW = gridDim.x * NWAVE;
    for (int r = gw; r < NTOK; r += NGW) {
        const bool lat = r < NLAT; const int pos = lat ? (r & (LSEQ - 1)) : ((r - NLAT) & (NC - 1)); const int slen = lat ? LSEQ : NC;
        const bf16_t* pr = P + (size_t)r * PW;
        {
            const u32x2 wv = *(const u32x2*)(pr + C_CQ + 4 * lane); float a0 = bflo(wv.x), a1 = bfhi(wv.x), a2 = bflo(wv.y), a3 = bfhi(wv.y);
            const float rstd = rsqrtf(wave_sum(a0 * a0 + a1 * a1 + a2 * a2 + a3 * a3) * (1.f / 256.f) + EPS); const f32x4 g = *(const f32x4*)(w.q_a_g + 4 * lane);
            u32x2 o; o.x = cvtpk(a0 * rstd * g.x, a1 * rstd * g.y); o.y = cvtpk(a2 * rstd * g.z, a3 * rstd * g.w); *(u32x2*)(CQN + (size_t)r * 256 + 4 * lane) = o; }
        {
            const unsigned wv = *(const unsigned*)(pr + C_CKV + 2 * lane); const float a0 = bflo(wv), a1 = bfhi(wv);
            const float rstd = rsqrtf(wave_sum(a0 * a0 + a1 * a1) * (1.f / 128.f) + EPS);
            *(unsigned*)(CKVN + (size_t)r * 128 + 2 * lane) = cvtpk(a0 * rstd * w.kv_a_g[2 * lane], a1 * rstd * w.kv_a_g[2 * lane + 1]); }
        if (lane < 16) *(unsigned*)(KR + (size_t)r * 32 + 2 * lane) = *(const unsigned*)(pr + C_KR + 2 * lane);
        {
            float acc[8];
#pragma unroll
            for (int e = 0; e < 8; ++e) acc[e] = w.conv_b[8 * lane + e];
#pragma unroll
            for (int t = 0; t < 4; ++t) { const int pp = pos + t - 2;
                if (pp >= 0 && pp < slen) { float xv[8]; load8(pr + (ptrdiff_t)(t - 2) * PW + C_LX + 8 * lane, xv);
#pragma unroll
                    for (int e = 0; e < 8; ++e) acc[e] += xv[e] * w.conv_w[t * 512 + 8 * lane + e]; } }
            store8(XC + (size_t)r * 512 + 8 * lane, acc); }
        *(u32x4*)(LG + (size_t)r * 512 + 8 * lane) = *(const u32x4*)(pr + C_LG + 8 * lane);
        {
            float v[8]; load8(pr + C_SQ + 8 * lane, v);
            head64_norm_rope(v, w.swa_q_g, lane, lat, pos >> 6, pos & 63, 0.125f * LOG2E);
            store8(SQ + (size_t)r * 512 + 8 * lane, v); }
        {
            const int l16 = lane & 15; float v[8]; load8(pr + C_SK + 8 * l16, v);
            head64_norm_rope(v, w.swa_k_g, lane, lat, pos >> 6, pos & 63, 1.f);
            if (lane < 16) { store8(SK + (size_t)r * 128 + 8 * lane, v); *(u32x4*)(SV + (size_t)r * 128 + 8 * lane) = *(const u32x4*)(pr + C_SV + 8 * lane); } }
    }
}

struct FinW { const float *mla_q_g, *mla_k_g; };
DI void phase_finish(bf16_t* QR, bf16_t* KVR, const bf16_t* KR, const FinW& w, int nq_rows, const int WB) {
    const int lane = my_tid() & 63, wave = WB >> 6;
    const int gw = blockIdx.x * NWAVE + wave, NGW = gridDim.x * NWAVE;
    const int d = 2 * lane; const bool act = lane < 48, isr = lane >= 32 && lane < 48;
    const int dl = lane - 32; const int axis = (dl >> 3) & 1, half = (dl >> 2) & 1, i0 = 2 * (dl & 3);
    const float f0 = __builtin_amdgcn_exp2f(-(float)i0 * (LOG2_THETA / 8.f)), f1 = __builtin_amdgcn_exp2f(-(float)(i0 + 1) * (LOG2_THETA / 8.f));
    const float gq0 = act ? w.mla_q_g[d] : 0.f, gq1 = act ? w.mla_q_g[d + 1] : 0.f, gk0 = act ? w.mla_k_g[d] : 0.f, gk1 = act ? w.mla_k_g[d + 1] : 0.f;
    for (int r = gw; r < NTOK; r += NGW) {
        const bool lat = r < NLAT; const int pos = r & (LSEQ - 1); const float pa = (float)(axis ? (pos & 63) : (pos >> 6));
        float cs0 = 1.f, sn0 = 0.f, cs1 = 1.f, sn1 = 0.f;
        if (lat) { cs0 = __cosf(pa * f0); sn0 = __sinf(pa * f0); cs1 = __cosf(pa * f1); sn1 = __sinf(pa * f1); }
        unsigned krw = 0u; if (isr) krw = *(const unsigned*)(KR + (size_t)r * 32 + 2 * dl);
#pragma unroll 1
        for (int hh = 0; hh < 8; ++hh) {
            if (r < nq_rows) {
                bf16_t* qp = QR + (size_t)r * 768 + hh * 96 + d; unsigned wv = 0u; if (act) wv = *(const unsigned*)qp;
                float a0 = bflo(wv), a1 = bfhi(wv);
                const float rstd = rsqrtf(wave_sum(a0 * a0 + a1 * a1) * (1.f / 96.f) + EPS);
                a0 = a0 * rstd * gq0; a1 = a1 * rstd * gq1;
                const float p0 = SHX(a0, 4), p1 = SHX(a1, 4);
                if (isr) { const float r0 = half ? p0 : -p0, r1 = half ? p1 : -p1; a0 = a0 * cs0 + r0 * sn0; a1 = a1 * cs1 + r1 * sn1; }
                const float qsc = 0.10206207261596575f * LOG2E;
                if (act) *(unsigned*)qp = cvtpk(a0 * qsc, a1 * qsc);
            }
            {
                bf16_t* kp = KVR + (size_t)r * 1280 + hh * 160 + d; unsigned wv = 0u; if (lane < 32) wv = *(const unsigned*)kp; else if (isr) wv = krw;
                float a0 = bflo(wv), a1 = bfhi(wv);
                const float rstd = rsqrtf(wave_sum(a0 * a0 + a1 * a1) * (1.f / 96.f) + EPS);
                a0 = a0 * rstd * gk0; a1 = a1 * rstd * gk1;
                const float p0 = SHX(a0, 4), p1 = SHX(a1, 4);
                if (isr) { const float r0 = half ? p0 : -p0, r1 = half ? p1 : -p1; a0 = a0 * cs0 + r0 * sn0; a1 = a1 * cs1 + r1 * sn1; }
                if (act) *(unsigned*)kp = cvtpk(a0, a1);
            }
        }
    }
}

DI int scan_row(int b, int dir, int s) {
    if (s < NC) return NLAT + b * NC + (dir ? (NC - 1 - s) : s);
    const int l = s - NC; return b * LSEQ + (dir ? (LSEQ - 1 - l) : l);
}
DI void phase_scan(unsigned* AU, LAS unsigned char* L, const int WB) {
    LAS float* sA = (LAS float*)L; LAS float* sH = (LAS float*)(L + 2048);
    const int tid = my_tid(), ch = tid & 15, seg = tid >> 4;
    for (int u = blockIdx.x; u < NB * 2 * 32; u += gridDim.x) {
        const int cgp = u & 31, dir = (u >> 5) & 1, b = u >> 6;
        unsigned* base = AU + (size_t)dir * NTOK * 512 + cgp * 16 + ch;
        float A = 1.f, H = 0.f;
#pragma unroll 8
        for (int s = 0; s < 72; ++s) { const unsigned wv = base[(size_t)scan_row(b, dir, seg * 72 + s) * 512];
            const float a = __builtin_amdgcn_exp2f(bflo(wv)), uu = bfhi(wv); H = a * H + uu; A *= a; }
        sA[seg * 16 + ch] = A; sH[seg * 16 + ch] = H;
        __syncthreads();
        float h = 0.f;
        for (int s2 = 0; s2 < seg; ++s2) h = sA[s2 * 16 + ch] * h + sH[s2 * 16 + ch];
#pragma unroll 8
        for (int s = 0; s < 72; ++s) { unsigned* p = base + (size_t)scan_row(b, dir, seg * 72 + s) * 512; const unsigned wv = *p;
            const float a = __builtin_amdgcn_exp2f(bflo(wv)), uu = bfhi(wv); h = a * h + uu; *(float*)p = h; }
        __syncthreads();
    }
}

DI float gelu_tanh(float x) { const float z = 0.7978845608028654f * (x + 0.044715f * x * x * x); const float t = 1.f - 2.f / (1.f + __expf(2.f * z)); return 0.5f * x * (1.f + t); }
DI void group_out(float (&v)[8], const float* g, bf16_t* dst, int lane) {
    float ss = 0.f;
#pragma unroll
    for (int e = 0; e < 8; ++e) ss += v[e] * v[e];
    const float rstd = rsqrtf(wave_sum(ss) * (1.f / 512.f) + EPS);
#pragma unroll
    for (int e = 0; e < 8; ++e) v[e] = v[e] * rstd * g[e];
    store8(dst, v);
}
DI void phase_groupnorm(const bf16_t* OA, const float* HS, const bf16_t* LG, const bf16_t* OC, const float* gg, bf16_t* ON, int nrows, const int WB) {
    const int lane = my_tid() & 63, wave = WB >> 6;
    const int gw = blockIdx.x * NWAVE + wave, NGW = gridDim.x * NWAVE;
    for (int r = gw; r < nrows; r += NGW) {
        float v[8];
        load8(OA + (size_t)r * 768 + (lane >> 3) * 96 + (lane & 7) * 8, v);
        group_out(v, gg + 8 * lane, ON + (size_t)r * 1536 + 8 * lane, lane);
        float lg[8]; load8(LG + (size_t)r * 512 + 8 * lane, lg);
        const f32x4 f0 = *(const f32x4*)(HS + (size_t)r * 512 + 8 * lane), f1 = *(const f32x4*)(HS + (size_t)r * 512 + 8 * lane + 4);
        const f32x4 b0 = *(const f32x4*)(HS + ((size_t)NTOK + r) * 512 + 8 * lane), b1 = *(const f32x4*)(HS + ((size_t)NTOK + r) * 512 + 8 * lane + 4);
#pragma unroll
        for (int e = 0; e < 4; ++e) { v[e] = (f0[e] + b0[e]) * gelu_tanh(lg[e]); v[4 + e] = (f1[e] + b1[e]) * gelu_tanh(lg[4 + e]); }
        group_out(v, gg + 512 + 8 * lane, ON + (size_t)r * 1536 + 512 + 8 * lane, lane);
        load8(OC + (size_t)r * 512 + 8 * lane, v);
        group_out(v, gg + 1024 + 8 * lane, ON + (size_t)r * 1536 + 1024 + 8 * lane, lane);
    }
}
struct AttnU { const bf16_t *Q, *KA, *KB, *VA, *VB; bf16_t* O; int qs, ks, vs, os, na, nb, kb0, q0, W; float sink; int has_sink; };
#define MFMA32(a, b, c) __builtin_amdgcn_mfma_f32_32x32x16_bf16((a), (b), (c), 0, 0, 0)
template <int DQ> DI void attn_unit(const AttnU& a, LAS unsigned char* L, int tid, const int WB) {
    constexpr int KSTR = DQ * 2 + 16, VSTR = 136, KBUF = 64 * KSTR, VBUF = 64 * VSTR, NS = DQ / 16, CPR = DQ / 8, NCH = 64 * CPR;
    const int lane = tid & 63, wave = WB >> 6, r = lane & 31, h = lane >> 5;
    bf16x8 qf[NS];
    { const bf16_t* qrow = a.Q + (size_t)(wave * 32 + r) * a.qs + 8 * h;
#pragma unroll
      for (int s = 0; s < NS; ++s) qf[s] = *(const bf16x8*)(qrow + 16 * s); }
    f32x16 o0, o1;
#pragma unroll
    for (int i = 0; i < 16; ++i) { o0[i] = 0.f; o1[i] = 0.f; }
    float m = a.has_sink ? a.sink : -1e30f, l = (a.has_sink && h == 0) ? 1.f : 0.f;
    const int nt = (a.na + a.nb) >> 6;
    const int c0r = tid / CPR, c0c = tid % CPR, c1r = (tid + 512) / CPR, c1c = (tid + 512) % CPR, vkey = tid >> 3, vc = tid & 7;
    u32x4 kreg0, kreg1 = {0u, 0u, 0u, 0u}, vreg;
    auto gload = [&](int t) {
        const int k0 = t * 64; const bf16_t* kp; const bf16_t* vp;
        if (k0 < a.na) { kp = a.KA + (size_t)k0 * a.ks; vp = a.VA + (size_t)k0 * a.vs; } else { kp = a.KB + (size_t)(k0 - a.na) * a.ks; vp = a.VB + (size_t)(k0 - a.na) * a.vs; }
        kreg0 = *(const u32x4*)(kp + (size_t)c0r * a.ks + c0c * 8);
        if (NCH > 512) { if (tid < NCH - 512) kreg1 = *(const u32x4*)(kp + (size_t)c1r * a.ks + c1c * 8); }
        vreg = *(const u32x4*)(vp + (size_t)vkey * a.vs + vc * 8);
    };
    auto lstore = [&](int buf) {
        *(LAS u32x4*)(L + buf * KBUF + c0r * KSTR + c0c * 16) = kreg0;
        if (NCH > 512) { if (tid < NCH - 512) *(LAS u32x4*)(L + buf * KBUF + c1r * KSTR + c1c * 16) = kreg1; }
        LAS unsigned char* vb = L + 2 * KBUF + buf * VBUF + (8 * vc) * VSTR + vkey * 2;
        *(LAS bf16_t*)(vb + 0 * VSTR) = (bf16_t)(vreg.x & 0xffffu); *(LAS bf16_t*)(vb + 1 * VSTR) = (bf16_t)(vreg.x >> 16);
        *(LAS bf16_t*)(vb + 2 * VSTR) = (bf16_t)(vreg.y & 0xffffu); *(LAS bf16_t*)(vb + 3 * VSTR) = (bf16_t)(vreg.y >> 16);
        *(LAS bf16_t*)(vb + 4 * VSTR) = (bf16_t)(vreg.z & 0xffffu); *(LAS bf16_t*)(vb + 5 * VSTR) = (bf16_t)(vreg.z >> 16);
        *(LAS bf16_t*)(vb + 6 * VSTR) = (bf16_t)(vreg.w & 0xffffu); *(LAS bf16_t*)(vb + 7 * VSTR) = (bf16_t)(vreg.w >> 16);
    };
    const int iq = a.q0 + wave * 32 + r, iq0 = a.q0 + wave * 32;
    gload(0);
    for (int t = 0; t < nt; ++t) {
        const int buf = t & 1;
        lstore(buf);
        __syncthreads();
        if (t + 1 < nt) gload(t + 1);
        const int k0 = t * 64; const bool masked = (k0 >= a.na) && (a.W < LSEQ); const int kpos0 = a.kb0 + (k0 - a.na);
        LAS unsigned char* Kb = L + buf * KBUF; LAS unsigned char* Vb = L + 2 * KBUF + buf * VBUF;
#pragma unroll
        for (int kh = 0; kh < 2; ++kh) {
            const int j0 = kpos0 + 32 * kh;
            if (masked && (j0 > iq0 + 31 + a.W || j0 + 31 < iq0 - a.W)) continue;
            f32x16 s;
#pragma unroll
            for (int i = 0; i < 16; ++i) s[i] = 0.f;
#pragma unroll
            for (int s_ = 0; s_ < NS; ++s_) { const bf16x8 kf = *(const LAS bf16x8*)(Kb + (32 * kh + r) * KSTR + (16 * s_ + 8 * h) * 2); s = MFMA32(kf, qf[s_], s); }
            if (masked) {
#pragma unroll
                for (int i = 0; i < 16; ++i) { const int j = j0 + (i & 3) + 8 * (i >> 2) + 4 * h; const int dlt = iq - j; if (dlt > a.W || dlt < -a.W) s[i] = -1e30f; }
            }
            float mx = s[0];
#pragma unroll
            for (int i = 1; i < 16; ++i) mx = fmaxf(mx, s[i]);
            mx = fmaxf(mx, SHX(mx, 32));
            const float mnew = fmaxf(m, mx); const float alpha = __builtin_amdgcn_exp2f(m - mnew); m = mnew;
            float ls = 0.f;
#pragma unroll
            for (int i = 0; i < 16; ++i) { s[i] = __builtin_amdgcn_exp2f(s[i] - mnew); ls += s[i]; }
            l = l * alpha + ls;
#pragma unroll
            for (int i = 0; i < 16; ++i) { o0[i] *= alpha; o1[i] *= alpha; }
            u32x4 pw0, pw1;
            pw0.x = cvtpk(s[0], s[1]); pw0.y = cvtpk(s[2], s[3]); pw0.z = cvtpk(s[4], s[5]); pw0.w = cvtpk(s[6], s[7]);
            pw1.x = cvtpk(s[8], s[9]); pw1.y = cvtpk(s[10], s[11]); pw1.z = cvtpk(s[12], s[13]); pw1.w = cvtpk(s[14], s[15]);
            const bf16x8 pf0 = __builtin_bit_cast(bf16x8, pw0), pf1 = __builtin_bit_cast(bf16x8, pw1);
#pragma unroll
            for (int s2 = 0; s2 < 2; ++s2) {
                const bf16x8 pf = s2 ? pf1 : pf0;
#pragma unroll
                for (int blk = 0; blk < 2; ++blk) {
                    const LAS unsigned char* va = Vb + (32 * blk + r) * VSTR + (32 * kh + 16 * s2 + 4 * h) * 2;
                    const s16x4 lo = *(const LAS s16x4*)va, hi = *(const LAS s16x4*)(va + 16);
                    const bf16x8 vf = __builtin_shufflevector(lo, hi, 0, 1, 2, 3, 4, 5, 6, 7);
                    if (blk == 0) o0 = MFMA32(vf, pf, o0); else o1 = MFMA32(vf, pf, o1);
                }
            }
        }
    }
    l += SHX(l, 32);
    const float inv = 1.f / l;
    bf16_t* orow = a.O + (size_t)(wave * 32 + r) * a.os;
#pragma unroll
    for (int g = 0; g < 4; ++g) {
        u32x2 w0, w1; w0.x = cvtpk(o0[4 * g] * inv, o0[4 * g + 1] * inv); w0.y = cvtpk(o0[4 * g + 2] * inv, o0[4 * g + 3] * inv);
        w1.x = cvtpk(o1[4 * g] * inv, o1[4 * g + 1] * inv); w1.y = cvtpk(o1[4 * g + 2] * inv, o1[4 * g + 3] * inv);
        *(u32x2*)(orow + 8 * g + 4 * h) = w0; *(u32x2*)(orow + 32 + 8 * g + 4 * h) = w1;
    }
    __syncthreads();
}
DI void phase_swa(bf16_t* SQ, const bf16_t* SK, const bf16_t* SV, const float* sinkp, bool with_ctx, LAS unsigned char* L, const int WB) {
    const int tid = my_tid(); const int nu = 1024 + (with_ctx ? 128 : 0);
    for (int u = blockIdx.x; u < nu; u += gridDim.x) {
        AttnU a; a.qs = 512; a.ks = 128; a.vs = 128; a.os = 512; a.W = 128; a.has_sink = 1;
        if (u < 1024) { const int qb = u & 7, hq = (u >> 3) & 7, b = u >> 6; const int kvh = hq >> 2; const int q0 = qb * 256;
            a.sink = sinkp[hq] * LOG2E; a.q0 = q0; a.kb0 = q0 - 128 < 0 ? 0 : q0 - 128; const int ke = q0 + 384 > LSEQ ? LSEQ : q0 + 384; a.nb = ke - a.kb0; a.na = NC;
            a.Q = SQ + (size_t)(b * LSEQ + q0) * 512 + hq * 64; a.O = SQ + (size_t)(b * LSEQ + q0) * 512 + hq * 64;
            a.KA = SK + (size_t)(NLAT + b * NC) * 128 + kvh * 64; a.VA = SV + (size_t)(NLAT + b * NC) * 128 + kvh * 64;
            a.KB = SK + (size_t)(b * LSEQ + a.kb0) * 128 + kvh * 64; a.VB = SV + (size_t)(b * LSEQ + a.kb0) * 128 + kvh * 64;
        } else { const int v = u - 1024; const int hq = v & 7, b = v >> 3; const int kvh = hq >> 2;
            a.sink = sinkp[hq] * LOG2E; a.q0 = 0; a.kb0 = 0; a.nb = 0; a.na = NC;
            a.Q = SQ + (size_t)(NLAT + b * NC) * 512 + hq * 64; a.O = SQ + (size_t)(NLAT + b * NC) * 512 + hq * 64;
            a.KA = SK + (size_t)(NLAT + b * NC) * 128 + kvh * 64; a.VA = SV + (size_t)(NLAT + b * NC) * 128 + kvh * 64; a.KB = a.KA; a.VB = a.VA;
        }
        attn_unit<64>(a, L, tid, WB);
    }
}
DI void phase_mla(bf16_t* QR, const bf16_t* KVR, bool with_ctx, LAS unsigned char* L, const int WB) {
    const int tid = my_tid(); const int nu = 1024 + (with_ctx ? 128 : 0);
    for (int u = blockIdx.x; u < nu; u += gridDim.x) {
        AttnU a; a.qs = 768; a.ks = 1280; a.vs = 1280; a.os = 768; a.W = 1 << 20; a.has_sink = 0; a.sink = 0.f; a.q0 = 0; a.kb0 = 0; a.na = NC;
        if (u < 1024) { const int qb = u & 7, hh = (u >> 3) & 7, b = u >> 6;
            a.nb = LSEQ; a.Q = QR + (size_t)(b * LSEQ + qb * 256) * 768 + hh * 96; a.O = a.Q ? QR + (size_t)(b * LSEQ + qb * 256) * 768 + hh * 96 : nullptr;
            a.KA = KVR + (size_t)(NLAT + b * NC) * 1280 + hh * 160; a.KB = KVR + (size_t)(b * LSEQ) * 1280 + hh * 160;
        } else { const int v = u - 1024; const int hh = v & 7, b = v >> 3;
            a.nb = 0; a.Q = QR + (size_t)(NLAT + b * NC) * 768 + hh * 96; a.O = QR + (size_t)(NLAT + b * NC) * 768 + hh * 96;
            a.KA = KVR + (size_t)(NLAT + b * NC) * 1280 + hh * 160; a.KB = a.KA;
        }
        a.VA = a.KA + 96; a.VB = a.KB + 96;
        attn_unit<96>(a, L, tid, WB);
    }
}

struct Args { const float* in[27]; float* out; unsigned char* ws; int ph_lo, ph_hi; };
typedef const __attribute__((address_space(4))) Args* KArgs;
DI KArgs launder(KArgs p) { asm volatile("" : "+s"(p)); return p; }
#define WSP(T, off) ((T*)(A->ws + (off)))
#define PHASE_BEGIN { const KArgs A = launder(ap0); {
#define PHASE_END   grid_bar(WSP(unsigned, 0), (++nbar) * gridDim.x, WB); } }
#define PHASE_END_LAST } }
#define LAYER_W(l) LayerW lw; lw.w_in = A->in[7] + (size_t)(l) * 1024 * 2208; lw.w_uq = A->in[9] + (size_t)(l) * 256 * 768; lw.w_ukv = A->in[11] + (size_t)(l) * 128 * 1024; \
        lw.gate_w = A->in[16] + (size_t)(l) * 2 * 2 * 8 * 64 * 64; lw.w_out = A->in[23] + (size_t)(l) * 1536 * 1024; lw.w_ff1 = A->in[25] + (size_t)(l) * 1024 * 4096; lw.w_ff2 = A->in[26] + (size_t)(l) * 4096 * 1024;
#define PHASE_END_MAYBE if (l == 0) grid_bar(WSP(unsigned, 0), (++nbar) * gridDim.x, WB); } }
DI void grid_bar(unsigned* ctr, unsigned target, const int WB) {
    asm volatile("s_waitcnt vmcnt(0)" ::: "memory");
    __syncthreads();
    if (my_tid() == 0) {
        __builtin_amdgcn_fence(__ATOMIC_RELEASE, "agent");
        asm volatile("s_waitcnt vmcnt(0)" ::: "memory");
        __hip_atomic_fetch_add(ctr, 1u, __ATOMIC_RELAXED, __HIP_MEMORY_SCOPE_AGENT);
        while (__hip_atomic_load(ctr, __ATOMIC_RELAXED, __HIP_MEMORY_SCOPE_AGENT) < target) __builtin_amdgcn_s_sleep(2);
        __builtin_amdgcn_fence(__ATOMIC_ACQUIRE, "agent");
        asm volatile("s_waitcnt vmcnt(0)" ::: "memory");
    }
    __syncthreads();
}
template <int l> DI void run_layer(const KArgs ap0, LAS unsigned char* L, unsigned& nbar, const int WB) {
        PHASE_BEGIN
            if (l == 1) { LAYER_W(1) phase_convert(lw, A->ws + WS_W, L, WB); }
            phase_norm(l == 0 ? A->in[0] : A->out, l == 0 ? A->in[2] : WSP(float, WS_XCRES), WSP(bf16_t, WS_HN), A->in[6] + l * 1024, WSP(float, WS_MOD) + (size_t)l * 17 * 6144, 0, NTOK, WB);
        PHASE_END
        PHASE_BEGIN
            pg8::Gemm g{WSP(bf16_t, WS_HN), WSP(bf16_t, WS_W + W_IN), NTOK, PW, 1024, 1024}; pg8::StaticOrder S; S.init(NTOK, PW, gridDim.x, blockIdx.x);
            pg8::EpiStore<0> E{WSP(bf16_t, WS_P), PW};
            pg8::gemm_phase<pg8::EpiStore<0>, pg8::StaticOrder, true, true>(L, g, S, E, WB);
        PHASE_END
        PHASE_BEGIN
            PrepW pw{A->in[8] + l * 256, A->in[10] + l * 128, A->in[14] + l * 4 * 512, A->in[15] + l * 512, A->in[19] + l * 64, A->in[20] + l * 64};
#ifndef SK_PREP
            phase_prep(WSP(bf16_t, WS_P), pw, WSP(bf16_t, WS_CQN), WSP(bf16_t, WS_CKVN), WSP(bf16_t, WS_KR), WSP(bf16_t, WS_XC), WSP(bf16_t, WS_LG), WSP(bf16_t, WS_SQ), WSP(bf16_t, WS_SK), WSP(bf16_t, WS_SV), WB);
#endif
        PHASE_END
        PHASE_BEGIN
            const int mrows = l == 1 ? NLAT : NTOK;
            { pg8::Gemm g{WSP(bf16_t, WS_CQN), WSP(bf16_t, WS_W + W_UQ), mrows, 768, 256, 256}; pg8::StaticOrder S; S.init(mrows, 768, gridDim.x, blockIdx.x);
              pg8::EpiStore<0> E{WSP(bf16_t, WS_QR), 768}; pg8::gemm_phase<pg8::EpiStore<0>, pg8::StaticOrder, true, true>(L, g, S, E, WB); }
            { pg8::Gemm g{WSP(bf16_t, WS_CKVN), WSP(bf16_t, WS_W + W_UKV), NTOK, 1280, 128, 128}; pg8::StaticOrder S; S.init(NTOK, 1280, gridDim.x, blockIdx.x);
              pg8::EpiStore<0> E{WSP(bf16_t, WS_KVR), 1280}; pg8::gemm_phase<pg8::EpiStore<0>, pg8::StaticOrder, true, true>(L, g, S, E, WB); }
#ifndef SK_GATE
#pragma unroll 1
            for (int j = 0; j < 4; ++j) { pg8::Gemm g{WSP(bf16_t, WS_XC) + 128 * j, WSP(bf16_t, WS_W + W_G) + (size_t)j * 512 * 128, NTOK, 512, 128, 512}; pg8::StaticOrder S; S.init(NTOK, 512, gridDim.x, blockIdx.x);
              pg8::EpiGate E{WSP(bf16_t, WS_XC), WSP(unsigned, WS_AU), A->in[17] + l * 2048, A->in[18] + l * 1024, j, NTOK}; pg8::gemm_phase<pg8::EpiGate, pg8::StaticOrder, true, false>(L, g, S, E, WB); }
#endif
        PHASE_END
        PHASE_BEGIN
            FinW fw{A->in[12] + l * 96, A->in[13] + l * 96};
#ifndef SK_FIN
            phase_finish(WSP(bf16_t, WS_QR), WSP(bf16_t, WS_KVR), WSP(bf16_t, WS_KR), fw, l == 1 ? NLAT : NTOK, WB);
#endif
#ifndef SK_SCAN
            phase_scan(WSP(unsigned, WS_AU), L, WB);
#endif
#ifndef SK_ATTN
            phase_swa(WSP(bf16_t, WS_SQ), WSP(bf16_t, WS_SK), WSP(bf16_t, WS_SV), A->in[21] + l * 8, l == 0, L, WB);
#endif
        PHASE_END
        PHASE_BEGIN
#ifndef SK_ATTN
            phase_mla(WSP(bf16_t, WS_QR), WSP(bf16_t, WS_KVR), l == 0, L, WB);
#endif
        PHASE_END
        PHASE_BEGIN
            phase_groupnorm(WSP(bf16_t, WS_QR), WSP(float, WS_AU), WSP(bf16_t, WS_LG), WSP(bf16_t, WS_SQ), A->in[22] + l * 1536, WSP(bf16_t, WS_ON), l == 1 ? NLAT : NTOK, WB);
        PHASE_END
        PHASE_BEGIN
            const int mrows = l == 1 ? NLAT : NTOK;
            pg8::Gemm g{WSP(bf16_t, WS_ON), WSP(bf16_t, WS_W + W_OUT), mrows, 1024, 1536, 1536}; pg8::StaticOrder S; S.init(mrows, 1024, gridDim.x, blockIdx.x);
            pg8::EpiResid E{l == 0 ? A->in[0] : A->out, l == 0 ? A->in[2] : WSP(float, WS_XCRES), A->out, WSP(float, WS_XCRES), WSP(float, WS_MOD) + (size_t)l * 17 * 6144 + 2 * 1024};
#ifndef SK_RESID
            pg8::gemm_phase<pg8::EpiResid, pg8::StaticOrder, true, true>(L, g, S, E, WB);
#endif
        PHASE_END
        PHASE_BEGIN
            phase_norm(A->out, WSP(float, WS_XCRES), WSP(bf16_t, WS_HN), A->in[24] + l * 1024, WSP(float, WS_MOD) + (size_t)l * 17 * 6144, 3, l == 1 ? NLAT : NTOK, WB);
        PHASE_END
        PHASE_BEGIN
            const int mrows = l == 1 ? NLAT : NTOK;
            pg8::Gemm g{WSP(bf16_t, WS_HN), WSP(bf16_t, WS_W + W_FF1), mrows, 4096, 1024, 1024}; pg8::StaticOrder S; S.init(mrows, 4096, gridDim.x, blockIdx.x);
            pg8::EpiStore<2> E{WSP(bf16_t, WS_H), 4096}; pg8::gemm_phase<pg8::EpiStore<2>, pg8::StaticOrder, true, true>(L, g, S, E, WB);
        PHASE_END
        PHASE_BEGIN
            const int mrows = l == 1 ? NLAT : NTOK;
            pg8::Gemm g{WSP(bf16_t, WS_H), WSP(bf16_t, WS_W + W_FF2), mrows, 1024, 4096, 4096}; pg8::StaticOrder S; S.init(mrows, 1024, gridDim.x, blockIdx.x);
            pg8::EpiResid E{A->out, WSP(float, WS_XCRES), A->out, WSP(float, WS_XCRES), WSP(float, WS_MOD) + (size_t)l * 17 * 6144 + 5 * 1024};
#ifndef SK_RESID
            pg8::gemm_phase<pg8::EpiResid, pg8::StaticOrder, true, true>(L, g, S, E, WB);
#endif
        PHASE_END_MAYBE
}
__global__ void __launch_bounds__(NTHR, 2) fwd_megakernel(Args args_by_value) {
    extern __shared__ __attribute__((aligned(16))) unsigned char lds_raw[];
    LAS unsigned char* L = (LAS unsigned char*)lds_raw;
    cg::grid_group grid = cg::this_grid();
    const KArgs ap0 = (KArgs)__builtin_amdgcn_kernarg_segment_ptr();
    grid.sync();
    const int WB = __builtin_amdgcn_readfirstlane(threadIdx.x);
    unsigned nbar = 0;
    PHASE_BEGIN
#ifndef SK_MOD
        phase_mod(A->in[1], A->in[3], A->in[4], A->in[5], WSP(float, WS_MOD), L, WB);
#endif
        __syncthreads();
        LAYER_W(0)
        phase_convert(lw, A->ws + WS_W, L, WB);
    PHASE_END
    run_layer<0>(ap0, L, nbar, WB);
    run_layer<1>(ap0, L, nbar, WB);
}
constexpr int N_PHASES = 23;

extern "C" void kernel_launch(void* const* d_in, const int* in_sizes, int n_in, void* d_out, int out_size, void* d_ws, size_t ws_size, hipStream_t stream) {
    static int grid = 0;
    if (grid == 0) {
        if (n_in != 27 || ws_size < WS_END) { fprintf(stderr, "kernel_launch: unexpected n_in %d / ws_size %zu\n", n_in, ws_size); grid = -1; return; }
        int dev = 0, cus = 0, per_cu = 0;
        hipGetDevice(&dev); hipDeviceGetAttribute(&cus, hipDeviceAttributeMultiprocessorCount, dev);
        if (hipFuncSetAttribute((const void*)fwd_megakernel, hipFuncAttributeMaxDynamicSharedMemorySize, LDS_BYTES) != hipSuccess) { fprintf(stderr, "kernel_launch: hipFuncSetAttribute failed\n"); grid = -1; return; }
        if (hipOccupancyMaxActiveBlocksPerMultiprocessor(&per_cu, (const void*)fwd_megakernel, NTHR, LDS_BYTES) != hipSuccess || per_cu < 1) { fprintf(stderr, "kernel_launch: occupancy query says %d\n", per_cu); per_cu = 1; }
        (void)hipGetLastError();
        grid = cus;
        if (grid != 256) { fprintf(stderr, "kernel_launch: needs a 256-CU device (got %d)\n", grid); grid = -1; return; }
    }
    if (grid < 0) return;
    if (hipMemsetAsync(d_ws, 0, 256, stream) != hipSuccess) { fprintf(stderr, "memset failed\n"); return; }
    Args a{};
    for (int i = 0; i < 27; ++i) a.in[i] = (const float*)d_in[i];
    a.out = (float*)d_out; a.ws = (unsigned char*)d_ws; a.ph_lo = 0; a.ph_hi = N_PHASES;
    void* kargs[] = {&a};
    hipError_t e = hipLaunchCooperativeKernel((const void*)fwd_megakernel, dim3(grid), dim3(NTHR), kargs, LDS_BYTES, stream);
    if (e != hipSuccess) fprintf(stderr, "cooperative launch failed: %s (grid %d)\n", hipGetErrorString(e), grid);
}
```

```cpp
#include <hip/hip_runtime.h>
#include <hip/hip_cooperative_groups.h>
#include <cstdio>
#include <cstdint>
namespace cg = cooperative_groups;
namespace pg8 {
#define PG8_LAS __attribute__((address_space(3)))
typedef unsigned short bf16_t;
typedef short bf16x8 __attribute__((ext_vector_type(8)));
typedef float f32x4 __attribute__((ext_vector_type(4)));
typedef unsigned u32x4 __attribute__((ext_vector_type(4)));
constexpr int BM = 256, BK = 64, HALF = 128, HTB = HALF * BK * 2  , STAGE_BYTES = 8 * HTB, NXCD = 8, WGM = 8;

__host__ __device__ __forceinline__ int lds_byte(int r, int c) { const int st = (r >> 4) * 2 + (c >> 5), rr = r & 15, cc = c & 31, ob = rr * 64 + cc * 2; return st * 1024 + (ob ^ (((ob >> 9) & 1) << 5)); }
__host__ __device__ __forceinline__ void stage_rc(int b, int& R, int& C) { const int st = b / 1024, sb = b % 1024, swz = sb ^ (((sb >> 9) & 1) << 5); R = (st >> 1) * 16 + swz / 64; C = (st & 1) * 32 + (swz % 64) / 2; }
__host__ __device__ __forceinline__ int perm32(int rho) { const int n = rho >> 4, i = rho & 15; return 8 * (i >> 2) + 4 * n + (i & 3); }

struct Unit { int pm, pn; };
struct Gemm { const bf16_t* A; const bf16_t* Bt; int M, N, K, lda; };

struct StaticOrder {
    int nM, nN, nwg, G, c;
    __host__ __device__ void init(int M, int N, int G_, int c_) { nM = M / BM; nN = N / BM; nwg = nM * nN; G = G_; c = c_; }
    __host__ __device__ bool next(int i, Unit& u) const {
        const long L = (long)i * G + c; if (L >= nwg) return false;
        int wgid = (int)L; { const int q = nwg / NXCD, r = nwg % NXCD, xcd = wgid % NXCD, off = wgid / NXCD; wgid = (xcd < r ? xcd * (q + 1) : r * (q + 1) + (xcd - r) * q) + off; }
        const int nig = WGM * nN, gid = wgid / nig, fm = gid * WGM, gsz = (nM - fm) < WGM ? (nM - fm) : WGM;
        u.pm = fm + ((wgid % nig) % gsz); u.pn = (wgid % nig) / gsz; return true;
    }
    __device__ __forceinline__ void a_ready(const Unit&) const {}
    __device__ __forceinline__ void done(const Unit&) const {}
};

__device__ __forceinline__ unsigned cvt_pk_bf16(float lo, float hi) { unsigned r; asm volatile("v_cvt_pk_bf16_f32 %0, %1, %2" : "=v"(r) : "v"(lo), "v"(hi)); return r; }
typedef float f32x2 __attribute__((ext_vector_type(2)));
template <class Epi, class Sched, bool ALIGN_EPI = false, bool SP2 = false>
__device__ __forceinline__ void gemm_phase(PG8_LAS unsigned char* lds, const Gemm g, const Sched& S, const Epi& E, const int WB) {
    int tid_l = WB + (int)__builtin_amdgcn_mbcnt_hi(~0u, __builtin_amdgcn_mbcnt_lo(~0u, 0u)); asm volatile("" : "+v"(tid_l)); const int tid = tid_l, wid = __builtin_amdgcn_readfirstlane(tid >> 6), lane = tid & 63, wr = wid >> 2, wc = wid & 3, fr = lane & 15, fq = lane >> 4;
    const int K = g.K, nt = K / BK;
    unsigned voffA[2], voffB[2];
#pragma unroll
    for (int i = 0; i < 2; ++i) { int R, C; stage_rc(tid * 16 + i * 8192, R, C); const int Rb = Epi::PERM ? ((R & ~31) + perm32(R & 31)) : R;
        voffA[i] = (unsigned)(R * g.lda + C) * 2u; voffB[i] = (unsigned)(Rb * K + C) * 2u; }
    const size_t kstep = (size_t)(BK * 2);
    const size_t hstepA = (size_t)HALF * g.lda * 2, hstepB = (size_t)HALF * K * 2;
    const size_t tstepA = 2 * hstepA, tstepB = 2 * hstepB;
    const unsigned ldsw = (unsigned)wid * 1024u;
    const int aoff = lds_byte(wr * 64 + fr, fq * 8), boff = lds_byte(wc * 32 + fr, fq * 8);
#define PG8_SA(b, h) (((b) * 2 + (h)) * HTB)
#define PG8_SB(b, h) ((4 + (b) * 2 + (h)) * HTB)
#define PG8_STAGE(bufoff, gbase, voff) do { _Pragma("unroll") for (int _i = 0; _i < 2; ++_i) \
        __builtin_amdgcn_global_load_lds((const unsigned*)((const char*)(gbase) + (voff)[_i]), (PG8_LAS unsigned*)(lds + (bufoff) + ldsw + _i * 8192), 16, 0, 0); } while (0)
#define PG8_LDA(dst, b, h) do { _Pragma("unroll") for (int m = 0; m < 4; ++m) _Pragma("unroll") for (int k = 0; k < 2; ++k) dst[m][k] = *(const PG8_LAS bf16x8*)(lds + PG8_SA(b, h) + aoff + m * 2048 + k * 1024); } while (0)
#define PG8_LDB(dst, b, h) do { _Pragma("unroll") for (int n = 0; n < 2; ++n) _Pragma("unroll") for (int k = 0; k < 2; ++k) dst[n][k] = *(const PG8_LAS bf16x8*)(lds + PG8_SB(b, h) + boff + n * 2048 + k * 1024); } while (0)
#define PG8_MMA(ai, bj, At, Bt) do { __builtin_amdgcn_s_setprio(1); _Pragma("unroll") for (int m = 0; m < 4; ++m) _Pragma("unroll") for (int n = 0; n < 2; ++n) _Pragma("unroll") for (int k = 0; k < 2; ++k) \
        acc[ai][bj][m][n] = __builtin_amdgcn_mfma_f32_16x16x32_bf16(Bt[n][k], At[m][k], acc[ai][bj][m][n], 0, 0, 0); __builtin_amdgcn_s_setprio(0); } while (0)
#define PG8_WAIT_V(n) asm volatile("s_waitcnt vmcnt(" #n ")" ::: "memory")
#define PG8_WAIT_L(n) asm volatile("s_waitcnt lgkmcnt(" #n ")" ::: "memory")
#define PG8_BAR __builtin_amdgcn_s_barrier()
#define PG8_SCHED __builtin_amdgcn_sched_barrier(0)
    Unit cur, nxt; int ui = 0;
    if (!S.next(0, cur)) return;
    f32x4 acc[2][2][4][2];
#pragma unroll
    for (int a = 0; a < 2; ++a)
#pragma unroll
        for (int b = 0; b < 2; ++b)
#pragma unroll
            for (int m = 0; m < 4; ++m)
#pragma unroll
                for (int n = 0; n < 2; ++n) acc[a][b][m][n] = (f32x4){0.f, 0.f, 0.f, 0.f};
    bf16x8 At[4][2], B0[2][2], B1[2][2];
    const char* cA = (const char*)g.A + (size_t)cur.pm * tstepA; const char* cB = (const char*)g.Bt + (size_t)cur.pn * tstepB;
    S.a_ready(cur);
    if constexpr (SP2) {
        PG8_STAGE(PG8_SB(0, 0), cB, voffB); PG8_STAGE(PG8_SB(0, 1), cB + hstepB, voffB); PG8_STAGE(PG8_SA(0, 0), cA, voffA); PG8_STAGE(PG8_SA(0, 1), cA + hstepA, voffA);
        if (wr == 1) PG8_BAR;
        PG8_WAIT_V(2); PG8_BAR;
        PG8_STAGE(PG8_SB(1, 0), cB + kstep, voffB); PG8_STAGE(PG8_SA(1, 0), cA + kstep, voffA); PG8_STAGE(PG8_SB(1, 1), cB + hstepB + kstep, voffB);
        PG8_WAIT_V(6); PG8_BAR;
    } else {
        PG8_STAGE(PG8_SB(0, 0), cB, voffB); PG8_STAGE(PG8_SA(0, 0), cA, voffA); PG8_STAGE(PG8_SB(0, 1), cB + hstepB, voffB); PG8_STAGE(PG8_SA(0, 1), cA + hstepA, voffA);
        if (wr == 1) PG8_BAR;
        PG8_WAIT_V(4); PG8_BAR;
        PG8_STAGE(PG8_SB(1, 0), cB + kstep, voffB); PG8_STAGE(PG8_SA(1, 0), cA + kstep, voffA); PG8_STAGE(PG8_SB(1, 1), cB + hstepB + kstep, voffB);
        PG8_WAIT_V(6); PG8_BAR;
    }
    for (;;) {
        const bool has_next = S.next(ui + 1, nxt);
        const char* nA = has_next ? (const char*)g.A + (size_t)nxt.pm * tstepA : cA; const char* nB = has_next ? (const char*)g.Bt + (size_t)nxt.pn * tstepB : cB;
        for (int t = 0; t < nt; t += 2) {
            const bool last = (t == nt - 2);
            const char* a1 = cA + (size_t)(t + 1) * kstep;
            const char* a2 = last ? nA : cA + (size_t)(t + 2) * kstep; const char* b2 = last ? nB : cB + (size_t)(t + 2) * kstep;
            const char* a3 = a2 + kstep; const char* b3 = b2 + kstep;
            if (last && has_next) S.a_ready(nxt);
            if constexpr (SP2) {
            PG8_LDB(B0, 0, 0); PG8_LDB(B1, 0, 1); PG8_SCHED; PG8_LDA(At, 0, 0); PG8_STAGE(PG8_SA(1, 1), a1 + hstepA, voffA);
            PG8_WAIT_V(8); PG8_WAIT_L(0); PG8_BAR; PG8_MMA(0, 0, At, B0); PG8_MMA(0, 1, At, B1); PG8_BAR; PG8_SCHED;
            PG8_LDA(At, 0, 1); PG8_STAGE(PG8_SB(0, 0), b2, voffB); PG8_STAGE(PG8_SB(0, 1), b2 + hstepB, voffB); PG8_STAGE(PG8_SA(0, 0), a2, voffA);
            PG8_WAIT_V(8); PG8_WAIT_L(0); PG8_BAR; PG8_MMA(1, 0, At, B0); PG8_MMA(1, 1, At, B1); PG8_BAR; PG8_SCHED;
            PG8_LDB(B0, 1, 0); PG8_LDB(B1, 1, 1); PG8_SCHED; PG8_LDA(At, 1, 0); PG8_STAGE(PG8_SA(0, 1), a2 + hstepA, voffA);
            PG8_WAIT_V(8); PG8_WAIT_L(0); PG8_BAR; PG8_MMA(0, 0, At, B0); PG8_MMA(0, 1, At, B1); PG8_BAR; PG8_SCHED;
            PG8_LDA(At, 1, 1); PG8_STAGE(PG8_SB(1, 0), b3, voffB); PG8_STAGE(PG8_SB(1, 1), b3 + hstepB, voffB); PG8_STAGE(PG8_SA(1, 0), a3, voffA);
            PG8_WAIT_V(8); PG8_WAIT_L(0); PG8_BAR; PG8_MMA(1, 0, At, B0); PG8_MMA(1, 1, At, B1); PG8_BAR; PG8_SCHED;
            } else {
            PG8_LDB(B0, 0, 0); PG8_SCHED; PG8_LDA(At, 0, 0); PG8_STAGE(PG8_SA(1, 1), a1 + hstepA, voffA);
            PG8_WAIT_L(8); PG8_BAR; PG8_WAIT_L(0); PG8_MMA(0, 0, At, B0); PG8_BAR; PG8_SCHED;
            PG8_LDB(B1, 0, 1); PG8_STAGE(PG8_SB(0, 0), b2, voffB);
            PG8_BAR; PG8_WAIT_L(0); PG8_MMA(0, 1, At, B1); PG8_BAR;
            PG8_LDA(At, 0, 1); PG8_STAGE(PG8_SA(0, 0), a2, voffA);
            PG8_BAR; PG8_WAIT_L(0); PG8_MMA(1, 0, At, B0); PG8_BAR; PG8_SCHED;
            PG8_STAGE(PG8_SB(0, 1), b2 + hstepB, voffB);
            PG8_WAIT_V(6); PG8_BAR; PG8_MMA(1, 1, At, B1); PG8_BAR;
            PG8_LDB(B0, 1, 0); PG8_SCHED; PG8_LDA(At, 1, 0); PG8_STAGE(PG8_SA(0, 1), a2 + hstepA, voffA);
            PG8_WAIT_L(8); PG8_BAR; PG8_WAIT_L(0); PG8_MMA(0, 0, At, B0); PG8_BAR; PG8_SCHED;
            PG8_LDB(B1, 1, 1); PG8_STAGE(PG8_SB(1, 0), b3, voffB);
            PG8_BAR; PG8_WAIT_L(0); PG8_MMA(0, 1, At, B1); PG8_BAR;
            PG8_LDA(At, 1, 1); PG8_STAGE(PG8_SA(1, 0), a3, voffA);
            PG8_BAR; PG8_WAIT_L(0); PG8_MMA(1, 0, At, B0); PG8_BAR; PG8_SCHED;
            PG8_STAGE(PG8_SB(1, 1), b3 + hstepB, voffB);
            PG8_WAIT_V(6); PG8_BAR; PG8_MMA(1, 1, At, B1); PG8_BAR;
            }
        }
        if constexpr (ALIGN_EPI) { if (wr == 0) PG8_BAR; }
        if constexpr (!Epi::AFTER_DRAIN) { E(acc, cur, wr, wc, fr, fq); S.done(cur); }
        if (!has_next) break;
#pragma unroll
        for (int a = 0; a < 2; ++a)
#pragma unroll
            for (int b = 0; b < 2; ++b)
#pragma unroll
                for (int m = 0; m < 4; ++m)
#pragma unroll
                    for (int n = 0; n < 2; ++n) acc[a][b][m][n] = (f32x4){0.f, 0.f, 0.f, 0.f};
        cur = nxt; cA = nA; cB = nB; ++ui;
        if constexpr (ALIGN_EPI) { if (wr == 1) PG8_BAR; }
    }
    PG8_WAIT_V(0);
    if constexpr (!ALIGN_EPI) { if (wr == 0) PG8_BAR; }
    PG8_BAR;
    if constexpr (Epi::AFTER_DRAIN) { E.fused(acc, cur, wr, wc, fr, fq, lds, wid, lane); S.done(cur); }
#undef PG8_SA
#undef PG8_SB
#undef PG8_STAGE
#undef PG8_LDA
#undef PG8_LDB
#undef PG8_MMA
#undef PG8_WAIT_V
#undef PG8_WAIT_L
#undef PG8_BAR
#undef PG8_SCHED
}
}
namespace pg8 {
typedef unsigned u32x2v __attribute__((ext_vector_type(2)));
template <int ACT> struct EpiStore {
    static constexpr bool PERM = true, AFTER_DRAIN = false;
    bf16_t* O; int ldc;
    __device__ __forceinline__ void operator()(const f32x4 (&acc)[2][2][4][2], const Unit& u, int wr, int wc, int fr, int fq) const {
        const int row0 = u.pm * BM + wr * 64 + fr; const int col0 = u.pn * BM + wc * 32 + 8 * fq;
#pragma unroll
        for (int ai = 0; ai < 2; ++ai)
#pragma unroll
            for (int m = 0; m < 4; ++m) { bf16_t* rowp = O + (size_t)(row0 + ai * HALF + m * 16) * ldc + col0;
#pragma unroll
                for (int bj = 0; bj < 2; ++bj) { f32x4 v0 = acc[ai][bj][m][0], v1 = acc[ai][bj][m][1];
                    if (ACT == 2) {
#pragma unroll
                        for (int e = 0; e < 4; ++e) { float a = fmaxf(v0[e], 0.f), b = fmaxf(v1[e], 0.f); v0[e] = a * a; v1[e] = b * b; } }
                    u32x4 w; w.x = cvt_pk_bf16(v0[0], v0[1]); w.y = cvt_pk_bf16(v0[2], v0[3]); w.z = cvt_pk_bf16(v1[0], v1[1]); w.w = cvt_pk_bf16(v1[2], v1[3]);
                    *(u32x4*)(rowp + bj * HALF) = w; } }
    }
};
struct EpiResid {
    static constexpr bool PERM = false, AFTER_DRAIN = false;
    const float* res_lat; const float* res_ctx; float* out_lat; float* out_ctx; const float* gate;
    __device__ __forceinline__ void operator()(const f32x4 (&acc)[2][2][4][2], const Unit& u, int wr, int wc, int fr, int fq) const {
        const bool lat = u.pm < 128; const int mr = lat ? (u.pm >> 3) : 16;
        const float* rb = lat ? res_lat + (size_t)u.pm * BM * 1024 : res_ctx + (size_t)(u.pm - 128) * BM * 1024;
        float* ob = lat ? out_lat + (size_t)u.pm * BM * 1024 : out_ctx + (size_t)(u.pm - 128) * BM * 1024;
        const float* gp = gate + (size_t)mr * 6144;
#pragma unroll
        for (int bj = 0; bj < 2; ++bj)
#pragma unroll
            for (int n = 0; n < 2; ++n) { const int col = u.pn * BM + bj * HALF + wc * 32 + n * 16 + 4 * fq; const f32x4 g = *(const f32x4*)(gp + col);
#pragma unroll
                for (int ai = 0; ai < 2; ++ai)
#pragma unroll
                    for (int m = 0; m < 4; ++m) { const size_t off = (size_t)(ai * HALF + wr * 64 + m * 16 + fr) * 1024 + col;
                        const f32x4 r = *(const f32x4*)(rb + off); *(f32x4*)(ob + off) = r + g * acc[ai][bj][m][n]; } }
    }
};
struct EpiGate {
    static constexpr bool PERM = false, AFTER_DRAIN = false;
    const bf16_t* XC; unsigned* AU; const float* gb; const float* lam; int j; int ntok;
    __device__ __forceinline__ void operator()(const f32x4 (&acc)[2][2][4][2], const Unit& u, int wr, int wc, int fr, int fq) const {
        const int ch = 128 * j + 64 * u.pn + 16 * wc + 4 * fq;
#pragma unroll
        for (int z = 0; z < 2; ++z) {
            const f32x4 br = *(const f32x4*)(gb + z * 1024 + ch), bi = *(const f32x4*)(gb + z * 1024 + 512 + ch);
            const f32x4 lm = *(const f32x4*)(lam + z * 512 + ch);
            f32x4 sp;
#pragma unroll
            for (int i = 0; i < 4; ++i) sp[i] = __logf(1.f + __expf(-lm[i])) * (-8.f * 1.4426950408889634f);
#pragma unroll
            for (int ai = 0; ai < 2; ++ai)
#pragma unroll
                for (int m = 0; m < 4; ++m) { const int row = u.pm * BM + ai * HALF + wr * 64 + m * 16 + fr;
                    const unsigned o = (unsigned)row * 512u + (unsigned)ch;
                    const u32x2v xw = *(const u32x2v*)(XC + o);
                    float x[4]; x[0] = __uint_as_float(xw.x << 16); x[1] = __uint_as_float(xw.x & 0xffff0000u); x[2] = __uint_as_float(xw.y << 16); x[3] = __uint_as_float(xw.y & 0xffff0000u);
                    const f32x4 vr = acc[ai][z][m][0], vi = acc[ai][z][m][1];
                    u32x4 ov;
#pragma unroll
                    for (int i = 0; i < 4; ++i) {
                        const float rr = 1.f / (1.f + __expf(-(vr[i] + br[i]))), jj = 1.f / (1.f + __expf(-(vi[i] + bi[i])));
                        const float la = rr * sp[i];
                        const float uu = sqrtf(fmaxf(1.f - __builtin_amdgcn_exp2f(2.f * la), 0.f)) * jj * x[i];
                        ov[i] = cvt_pk_bf16(la, uu); }
                    *(u32x4*)(AU + o + (unsigned)(z * ntok) * 512u) = ov; }
        }
    }
};
}
#define DI __device__ __forceinline__
#define LAS __attribute__((address_space(3)))
typedef unsigned short bf16_t;
typedef float f32x4 __attribute__((ext_vector_type(4)));
typedef float f32x2 __attribute__((ext_vector_type(2)));
typedef float f32x16 __attribute__((ext_vector_type(16)));
typedef short bf16x8 __attribute__((ext_vector_type(8)));
typedef short s16x4 __attribute__((ext_vector_type(4)));
typedef unsigned u32x4 __attribute__((ext_vector_type(4)));
typedef unsigned u32x2 __attribute__((ext_vector_type(2)));
typedef __bf16 bf16x2_t __attribute__((ext_vector_type(2)));

constexpr int NB = 16, LSEQ = 2048, NC = 256, DM = 1024, NLAT = NB * LSEQ, NCTX = NB * NC, NTOK = NLAT + NCTX;
constexpr int PW = 2304;
constexpr int C_CQ = 0, C_CKV = 256, C_KR = 384, C_LX = 416, C_LG = 928, C_SQ = 1440, C_SK = 1952, C_SV = 2080;
constexpr float EPS = 1e-6f, LOG2E = 1.4426950408889634f, LOG2_THETA = 13.287712379549449f;
constexpr int NTHR = 512, NWAVE = 8;
constexpr int LDS_BYTES = 147456;

constexpr size_t MiB = 1u << 20;
constexpr size_t WS_MOD = 1 * MiB;
constexpr size_t WS_W = 2 * MiB;
constexpr size_t W_IN = 0, W_UQ = W_IN + (size_t)2304 * 1024 * 2, W_UKV = W_UQ + (size_t)768 * 256 * 2, W_G = W_UKV + (size_t)1280 * 128 * 2,
                 W_OUT = W_G + (size_t)4 * 512 * 128 * 2, W_FF1 = W_OUT + (size_t)1024 * 1536 * 2, W_FF2 = W_FF1 + (size_t)4096 * 1024 * 2, W_END = W_FF2 + (size_t)1024 * 4096 * 2;
static_assert(W_END <= 25 * MiB, "weights");
constexpr size_t WS_XCRES = 27 * MiB;
constexpr size_t WS_R1 = 43 * MiB;
constexpr size_t WS_HN = WS_R1, WS_SK = WS_R1, WS_CKVN = WS_R1 + 9 * MiB, WS_CQN = WS_R1 + 18 * MiB, WS_XC = WS_R1 + 36 * MiB;
constexpr size_t WS_KVR = 115 * MiB;
constexpr size_t WS_ON = WS_R1;
constexpr size_t WS_P = 205 * MiB;
constexpr size_t WS_AU = WS_P;
constexpr size_t WS_QR = 367 * MiB;
constexpr size_t WS_SQ = 421 * MiB;
constexpr size_t WS_LG = 457 * MiB;
constexpr size_t WS_SV = 493 * MiB;
constexpr size_t WS_KR = 502 * MiB;
constexpr size_t WS_H = 115 * MiB;
constexpr size_t WS_END = 512 * MiB;
static_assert(WS_H + (size_t)NTOK * 4096 * 2 <= WS_LG, "H overlay");

DI int tid_from(int WB) { int t = WB + (int)__builtin_amdgcn_mbcnt_hi(~0u, __builtin_amdgcn_mbcnt_lo(~0u, 0u)); asm volatile("" : "+v"(t)); return t; }
#define my_tid() tid_from(WB)
DI float bf2f(bf16_t v) { return __uint_as_float((unsigned)v << 16); }
DI float bflo(unsigned w) { return __uint_as_float(w << 16); }
DI float bfhi(unsigned w) { return __uint_as_float(w & 0xffff0000u); }
DI unsigned cvtpk(float lo, float hi) { f32x2 v = {lo, hi}; bf16x2_t b = __builtin_convertvector(v, bf16x2_t); return __builtin_bit_cast(unsigned, b); }
DI float shx(float v, int o, int lane) { return __int_as_float(__builtin_amdgcn_ds_bpermute((lane ^ o) << 2, __float_as_int(v))); }
#define SHX(v, o) shx((v), (o), lane)
DI float wave_sum_(float v, int lane) {
#pragma unroll
    for (int o = 1; o < 64; o <<= 1) v += SHX(v, o);
    return v;
}
#define wave_sum(v) wave_sum_((v), lane)
DI float sigmoidf_(float x) { return 1.f / (1.f + __expf(-x)); }

DI void phase_mod(const float* c, const float* cctx, const float* w_mod, const float* b_mod, float* MOD, LAS unsigned char* L, const int WB) {
    LAS float* act = (LAS float*)L;
    LAS float* red = (LAS float*)(L + 17 * 1024 * 4);
    const int tid = my_tid(), lane = tid & 63, wave = WB >> 6;
    for (int i = tid; i < 17 * 1024; i += NTHR) { const int r = i >> 10, k = i & 1023; const float v = r < 16 ? c[r * 1024 + k] : cctx[k]; act[i] = v / (1.f + __expf(-v)); }
    __syncthreads();
    for (int item = blockIdx.x; item < 2 * 96; item += gridDim.x) {
        const int l = item / 96, cgp = item % 96, col = cgp * 64 + lane;
        const float* w = w_mod + (size_t)l * 1024 * 6144 + col;
        float acc[17];
#pragma unroll
        for (int r = 0; r < 17; ++r) acc[r] = 0.f;
#pragma unroll 4
        for (int k = wave * 128; k < wave * 128 + 128; ++k) { const float wv = w[(size_t)k * 6144];
#pragma unroll
            for (int r = 0; r < 17; ++r) acc[r] += act[r * 1024 + k] * wv; }
#pragma unroll
        for (int r = 0; r < 17; ++r) red[(wave * 17 + r) * 64 + lane] = acc[r];
        __syncthreads();
        for (int i = tid; i < 17 * 64; i += NTHR) { const int r = i >> 6, cl = i & 63; float s = b_mod[l * 6144 + cgp * 64 + cl];
#pragma unroll
            for (int w8 = 0; w8 < 8; ++w8) s += red[(w8 * 17 + r) * 64 + cl];
            MOD[((size_t)l * 17 + r) * 6144 + cgp * 64 + cl] = s; }
        __syncthreads();
    }
}

DI void transpose_item(const float* W, int K, int N, bf16_t* WT, int k0, int n0, int dst_row0, LAS float* scr, int lane) {
#pragma unroll 8
    for (int i = 0; i < 32; ++i) { const int kk = 2 * i + (lane >> 5); scr[kk * 33 + (lane & 31)] = W[(size_t)(k0 + kk) * N + n0 + (lane & 31)]; }
    asm volatile("s_waitcnt lgkmcnt(0)" ::: "memory");
    const int c = lane & 7;
#pragma unroll
    for (int j = 0; j < 4; ++j) { const int n = (lane >> 3) + 8 * j; const LAS float* s = scr + (8 * c) * 33 + n;
        u32x4 o; o.x = cvtpk(s[0 * 33], s[1 * 33]); o.y = cvtpk(s[2 * 33], s[3 * 33]); o.z = cvtpk(s[4 * 33], s[5 * 33]); o.w = cvtpk(s[6 * 33], s[7 * 33]);
        *(u32x4*)(WT + (size_t)(dst_row0 + n) * K + k0 + 8 * c) = o; }
    asm volatile("s_waitcnt lgkmcnt(0)" ::: "memory");
}
struct LayerW { const float *w_in, *w_uq, *w_ukv, *gate_w, *w_out, *w_ff1, *w_ff2; };
DI void phase_convert(const LayerW& lw, unsigned char* wsw, LAS unsigned char* L, const int WB) {
    const int tid = my_tid(), lane = tid & 63, wave = WB >> 6;
    LAS float* scr = (LAS float*)(L + wave * 16384);
    const int gw = blockIdx.x * NWAVE + wave, NGW = gridDim.x * NWAVE;
    bf16_t* win_t = (bf16_t*)(wsw + W_IN); bf16_t* wuq_t = (bf16_t*)(wsw + W_UQ); bf16_t* wukv_t = (bf16_t*)(wsw + W_UKV); bf16_t* wg_t = (bf16_t*)(wsw + W_G);
    bf16_t* wout_t = (bf16_t*)(wsw + W_OUT); bf16_t* wff1_t = (bf16_t*)(wsw + W_FF1); bf16_t* wff2_t = (bf16_t*)(wsw + W_FF2);
    constexpr int I_IN = 16 * 69, I_UQ = 4 * 24, I_UKV = 2 * 32, I_OUT = 24 * 32, I_F1 = 16 * 128, I_F2 = 64 * 32;
    constexpr int NITEMS = I_IN + I_UQ + I_UKV + I_OUT + I_F1 + I_F2;
#pragma unroll 1
    for (int it = gw; it < NITEMS; it += NGW) {
        int r = it;
        if (r < I_IN) { const int kb = r / 69, nb = r % 69; transpose_item(lw.w_in, 1024, 2208, win_t, 64 * kb, 32 * nb, 32 * nb, scr, lane); continue; } r -= I_IN;
        if (r < I_UQ) { const int kb = r / 24, nb = r % 24; transpose_item(lw.w_uq, 256, 768, wuq_t, 64 * kb, 32 * nb, 32 * nb, scr, lane); continue; } r -= I_UQ;
        if (r < I_UKV) { const int kb = r / 32, nb = r % 32; const int hh = nb >> 2, jb = nb & 3; const int dr = hh * 160 + (jb < 2 ? jb * 32 : 96 + (jb - 2) * 32);
            transpose_item(lw.w_ukv, 128, 1024, wukv_t, 64 * kb, 32 * nb, dr, scr, lane); continue; } r -= I_UKV;
        if (r < I_OUT) { const int kb = r / 32, nb = r % 32; transpose_item(lw.w_out, 1536, 1024, wout_t, 64 * kb, 32 * nb, 32 * nb, scr, lane); continue; } r -= I_OUT;
        if (r < I_F1) { const int kb = r / 128, nb = r % 128; transpose_item(lw.w_ff1, 1024, 4096, wff1_t, 64 * kb, 32 * nb, 32 * nb, scr, lane); continue; } r -= I_F1;
        { const int kb = r / 32, nb = r % 32; transpose_item(lw.w_ff2, 4096, 1024, wff2_t, 64 * kb, 32 * nb, 32 * nb, scr, lane); }
    }
    const int gt = blockIdx.x * NTHR + tid; constexpr int NGT = 256 * NTHR;
#pragma unroll 1
    for (int i = gt; i < 96 * 1024 / 2; i += NGT) ((unsigned*)(win_t + (size_t)2208 * 1024))[i] = 0u;
#pragma unroll 1
    for (int i = gt; i < 8 * 32 * 128 / 2; i += NGT) { const int hh = i / (32 * 64), rem = i % (32 * 64); ((unsigned*)(wukv_t + (size_t)(hh * 160 + 64) * 128))[rem] = 0u; }
#pragma unroll 1
    for (int i = gt; i < 4 * 512 * 128; i += NGT) { const int k = i & 127, p = (i >> 7) & 511, j = i >> 16;
        const int pn = p >> 8, z = (p >> 7) & 1, wc = (p >> 5) & 3, g = (p >> 4) & 1, fq = (p >> 2) & 3, ii = p & 3; const int cl = 64 * pn + 16 * wc + 4 * fq + ii;
        float v = 0.f; if ((k >> 6) == (cl >> 6)) { const int blk = 2 * j + (k >> 6); v = lw.gate_w[((((size_t)z * 2 + g) * 8 + blk) * 64 + (k & 63)) * 64 + (cl & 63)]; }
        wg_t[i] = (bf16_t)(cvtpk(v, 0.f) & 0xffffu); }
}

DI void norm_mod_row(const float* xrow, bf16_t* orow, const float* g, const float* shift, const float* scale, int lane) {
    f32x4 v[4]; float ss = 0.f;
#pragma unroll
    for (int j = 0; j < 4; ++j) { v[j] = *(const f32x4*)(xrow + 4 * lane + 256 * j); ss += (v[j].x * v[j].x + v[j].y * v[j].y) + (v[j].z * v[j].z + v[j].w * v[j].w); }
    const float rstd = rsqrtf(wave_sum(ss) * (1.f / 1024.f) + EPS);
#pragma unroll
    for (int j = 0; j < 4; ++j) { const int col = 4 * lane + 256 * j; const f32x4 gv = *(const f32x4*)(g + col), sh = *(const f32x4*)(shift + col), sc = *(const f32x4*)(scale + col);
        const f32x4 y = v[j] * rstd * gv * (sc + 1.f) + sh; u32x2 o; o.x = cvtpk(y.x, y.y); o.y = cvtpk(y.z, y.w); *(u32x2*)(orow + col) = o; }
}
DI void phase_norm(const float* xlat, const float* xctx, bf16_t* HN, const float* g, const float* modl, int chunk, int nrows, const int WB) {
    const int lane = my_tid() & 63, wave = WB >> 6;
    const int gw = blockIdx.x * NWAVE + wave, NGW = gridDim.x * NWAVE;
    for (int r = gw; r < nrows; r += NGW) {
        const bool lat = r < NLAT; const float* xr = lat ? xlat + (size_t)r * 1024 : xctx + (size_t)(r - NLAT) * 1024;
        const float* mp = modl + (size_t)(lat ? (r >> 11) : 16) * 6144 + chunk * 1024;
        norm_mod_row(xr, HN + (size_t)r * 1024, g, mp, mp + 1024, lane);
    }
}
DI void load8(const bf16_t* p, float (&v)[8]) { const u32x4 w = *(const u32x4*)p; v[0] = bflo(w.x); v[1] = bfhi(w.x); v[2] = bflo(w.y); v[3] = bfhi(w.y); v[4] = bflo(w.z); v[5] = bfhi(w.z); v[6] = bflo(w.w); v[7] = bfhi(w.w); }
DI void store8(bf16_t* p, const float (&v)[8]) { u32x4 w; w.x = cvtpk(v[0], v[1]); w.y = cvtpk(v[2], v[3]); w.z = cvtpk(v[4], v[5]); w.w = cvtpk(v[6], v[7]); *(u32x4*)p = w; }
DI void head64_norm_rope(float (&v)[8], const float* g, int lane, bool rope, int prow, int pcol, float outscale) {
    const int li = lane & 7;
    float ss = 0.f;
#pragma unroll
    for (int e = 0; e < 8; ++e) ss += v[e] * v[e];
    ss += SHX(ss, 1); ss += SHX(ss, 2); ss += SHX(ss, 4);
    const float rstd = rsqrtf(ss * (1.f / 64.f) + EPS);
    const int axis = li >> 2, half = (li >> 1) & 1; const float pos = (float)(axis ? pcol : prow);
#pragma unroll
    for (int e = 0; e < 8; ++e) v[e] = v[e] * rstd * g[8 * li + e];
#pragma unroll
    for (int e = 0; e < 8; ++e) { const float p = SHX(v[e], 2);
        if (rope) { const int i = 8 * (li & 1) + e; const float ang = pos * __builtin_amdgcn_exp2f(-(float)i * (LOG2_THETA / 16.f));
            const float cs = __cosf(ang), sn = __sinf(ang); const float rot = half ? p : -p; v[e] = v[e] * cs + rot * sn; } }
#pragma unroll
    for (int e = 0; e < 8; ++e) v[e] *= outscale;
}
struct PrepW { const float *q_a_g, *kv_a_g, *conv_w, *conv_b, *swa_q_g, *swa_k_g; };
DI void phase_prep(const bf16_t* P, const PrepW& w, bf16_t* CQN, bf16_t* CKVN, bf16_t* KR, bf16_t* XC, bf16_t* LG, bf16_t* SQ, bf16_t* SK, bf16_t* SV, const int WB) {
    const int lane = my_tid() & 63, wave = WB >> 6;
    const int gw = blockIdx.x * NWAVE + wave, NGW = gridDim.x * NWAVE;
    for (int r = gw; r < NTOK; r += NGW) {
        const bool lat = r < NLAT; const int pos = lat ? (r & (LSEQ - 1)) : ((r - NLAT) & (NC - 1)); const int slen = lat ? LSEQ : NC;
        const bf16_t* pr = P + (size_t)r * PW;
        {
            const u32x2 wv = *(const u32x2*)(pr + C_CQ + 4 * lane); float a0 = bflo(wv.x), a1 = bfhi(wv.x), a2 = bflo(wv.y), a3 = bfhi(wv.y);
            const float rstd = rsqrtf(wave_sum(a0 * a0 + a1 * a1 + a2 * a2 + a3 * a3) * (1.f / 256.f) + EPS); const f32x4 g = *(const f32x4*)(w.q_a_g + 4 * lane);
            u32x2 o; o.x = cvtpk(a0 * rstd * g.x, a1 * rstd * g.y); o.y = cvtpk(a2 * rstd * g.z, a3 * rstd * g.w); *(u32x2*)(CQN + (size_t)r * 256 + 4 * lane) = o; }
        {
            const unsigned wv = *(const unsigned*)(pr + C_CKV + 2 * lane); const float a0 = bflo(wv), a1 = bfhi(wv);
            const float rstd = rsqrtf(wave_sum(a0 * a0 + a1 * a1) * (1.f / 128.f) + EPS);
            *(unsigned*)(CKVN + (size_t)r * 128 + 2 * lane) = cvtpk(a0 * rstd * w.kv_a_g[2 * lane], a1 * rstd * w.kv_a_g[2 * lane + 1]); }
        if (lane < 16) *(unsigned*)(KR + (size_t)r * 32 + 2 * lane) = *(const unsigned*)(pr + C_KR + 2 * lane);
        {
            float acc[8];
#pragma unroll
            for (int e = 0; e < 8; ++e) acc[e] = w.conv_b[8 * lane + e];
#pragma unroll
            for (int t = 0; t < 4; ++t) { const int pp = pos + t - 2;
                if (pp >= 0 && pp < slen) { float xv[8]; load8(pr + (ptrdiff_t)(t - 2) * PW + C_LX + 8 * lane, xv);
#pragma unroll
                    for (int e = 0; e < 8; ++e) acc[e] += xv[e] * w.conv_w[t * 512 + 8 * lane + e]; } }
            store8(XC + (size_t)r * 512 + 8 * lane, acc); }
        *(u32x4*)(LG + (size_t)r * 512 + 8 * lane) = *(const u32x4*)(pr + C_LG + 8 * lane);
        {
            float v[8]; load8(pr + C_SQ + 8 * lane, v);
            head64_norm_rope(v, w.swa_q_g, lane, lat, pos >> 6, pos & 63, 0.125f * LOG2E);
            store8(SQ + (size_t)r * 512 + 8 * lane, v); }
        {
            const int l16 = lane & 15; float v[8]; load8(pr + C_SK + 8 * l16, v);
            head64_norm_rope(v, w.swa_k_g, lane, lat, pos >> 6, pos & 63, 1.f);
            if (lane < 16) { store8(SK + (size_t)r * 128 + 8 * lane, v); *(u32x4*)(SV + (size_t)r * 128 + 8 * lane) = *(const u32x4*)(pr + C_SV + 8 * lane); } }
    }
}

struct FinW { const float *mla_q_g, *mla_k_g; };
DI void load4(const bf16_t* p, float (&v)[4]) { const u32x2 w = *(const u32x2*)p; v[0] = bflo(w.x); v[1] = bfhi(w.x); v[2] = bflo(w.y); v[3] = bfhi(w.y); }
DI void store4(bf16_t* p, const float (&v)[4]) { u32x2 w; w.x = cvtpk(v[0], v[1]); w.y = cvtpk(v[2], v[3]); *(u32x2*)p = w; }
DI void head96_finish(float (&a)[8], float (&b)[4], const float (&g8)[8], const float (&g4)[4], const float (&cs)[4], const float (&sn)[4], bool half, float osc, int lane) {
    float ss = 0.f;
#pragma unroll
    for (int e = 0; e < 8; ++e) ss += a[e] * a[e];
#pragma unroll
    for (int e = 0; e < 4; ++e) ss += b[e] * b[e];
    ss += SHX(ss, 1); ss += SHX(ss, 2); ss += SHX(ss, 4);
    const float rstd = rsqrtf(ss * (1.f / 96.f) + EPS) ;
#pragma unroll
    for (int e = 0; e < 8; ++e) a[e] = a[e] * rstd * g8[e] * osc;
#pragma unroll
    for (int e = 0; e < 4; ++e) b[e] = b[e] * rstd * g4[e];
#pragma unroll
    for (int e = 0; e < 4; ++e) { const float p = SHX(b[e], 2); const float rot = half ? p : -p; b[e] = (b[e] * cs[e] + rot * sn[e]) * osc; }
}
DI void phase_finish(bf16_t* QR, bf16_t* KVR, const bf16_t* KR, const FinW& w, int nq_rows, const int WB) {
    const int lane = my_tid() & 63, wave = WB >> 6;
    const int gw = blockIdx.x * NWAVE + wave, NGW = gridDim.x * NWAVE;
    const int hh = lane >> 3, li = lane & 7;
    const int axis = li >> 2; const bool half = (li >> 1) & 1;
    float fr[4], gq8[8], gq4[4], gk8[8], gk4[4];
#pragma unroll
    for (int e = 0; e < 4; ++e) { fr[e] = __builtin_amdgcn_exp2f(-(float)(4 * (li & 1) + e) * (LOG2_THETA / 8.f)); gq4[e] = w.mla_q_g[64 + 4 * li + e]; gk4[e] = w.mla_k_g[64 + 4 * li + e]; }
#pragma unroll
    for (int e = 0; e < 8; ++e) { gq8[e] = w.mla_q_g[8 * li + e]; gk8[e] = w.mla_k_g[8 * li + e]; }
    for (int r = gw; r < NTOK; r += NGW) {
        const bool lat = r < NLAT; const int pos = r & (LSEQ - 1); const float pa = (float)(axis ? (pos & 63) : (pos >> 6));
        float cs[4], sn[4];
#pragma unroll
        for (int e = 0; e < 4; ++e) { cs[e] = lat ? __cosf(pa * fr[e]) : 1.f; sn[e] = lat ? __sinf(pa * fr[e]) : 0.f; }
        if (r < nq_rows) {
            bf16_t* qp = QR + (size_t)r * 768 + hh * 96; float a[8], b[4]; load8(qp + 8 * li, a); load4(qp + 64 + 4 * li, b);
            head96_finish(a, b, gq8, gq4, cs, sn, half, 0.10206207261596575f * LOG2E, lane);
            store8(qp + 8 * li, a); store4(qp + 64 + 4 * li, b);
        }
        {
            bf16_t* kp = KVR + (size_t)r * 1280 + hh * 160; float a[8], b[4]; load8(kp + 8 * li, a); load4(KR + (size_t)r * 32 + 4 * li, b);
            head96_finish(a, b, gk8, gk4, cs, sn, half, 1.f, lane);
            store8(kp + 8 * li, a); store4(kp + 64 + 4 * li, b);
        }
    }
}

DI int scan_row(int b, int dir, int s) {
    if (s < NC) return NLAT + b * NC + (dir ? (NC - 1 - s) : s);
    const int l = s - NC; return b * LSEQ + (dir ? (LSEQ - 1 - l) : l);
}
DI void phase_scan(unsigned* AU, LAS unsigned char* L, const int WB) {
    LAS float* sA = (LAS float*)L; LAS float* sH = (LAS float*)(L + 2048);
    const int tid = my_tid(), ch = tid & 15, seg = tid >> 4;
    for (int u = blockIdx.x; u < NB * 2 * 32; u += gridDim.x) {
        const int cgp = u & 31, dir = (u >> 5) & 1, b = u >> 6;
        unsigned* base = AU + (size_t)dir * NTOK * 512 + cgp * 16 + ch;
        unsigned wv[72];
        const int s0 = seg * 72;
        const int dstride = dir ? -512 : 512;
        const int jump = (scan_row(b, dir, 256) - scan_row(b, dir, 255)) * 512;
        const unsigned idx0 = (unsigned)scan_row(b, dir, s0) * 512u;
        unsigned idx = idx0;
#pragma unroll
        for (int s = 0; s < 72; ++s) { wv[s] = base[idx]; idx += (unsigned)((s0 + s == 255) ? jump : dstride); asm volatile("" : "+v"(idx)); }
        float A = 1.f, H = 0.f;
#pragma unroll
        for (int s = 0; s < 72; ++s) { const float a = __builtin_amdgcn_exp2f(bflo(wv[s])), uu = bfhi(wv[s]); H = a * H + uu; A *= a; }
        sA[seg * 16 + ch] = A; sH[seg * 16 + ch] = H;
        __syncthreads();
        float h = 0.f;
        for (int s2 = 0; s2 < seg; ++s2) h = sA[s2 * 16 + ch] * h + sH[s2 * 16 + ch];
        idx = idx0;
#pragma unroll
        for (int s = 0; s < 72; ++s) { const float a = __builtin_amdgcn_exp2f(bflo(wv[s])), uu = bfhi(wv[s]); h = a * h + uu; *(float*)(base + idx) = h; idx += (unsigned)((s0 + s == 255) ? jump : dstride); asm volatile("" : "+v"(idx)); }
        __syncthreads();
    }
}

DI float gelu_tanh(float x) { const float z = 0.7978845608028654f * (x + 0.044715f * x * x * x); const float t = 1.f - 2.f / (1.f + __expf(2.f * z)); return 0.5f * x * (1.f + t); }
DI void group_out(float (&v)[8], const float* g, bf16_t* dst, int lane) {
    float ss = 0.f;
#pragma unroll
    for (int e = 0; e < 8; ++e) ss += v[e] * v[e];
    const float rstd = rsqrtf(wave_sum(ss) * (1.f / 512.f) + EPS);
#pragma unroll
    for (int e = 0; e < 8; ++e) v[e] = v[e] * rstd * g[e];
    store8(dst, v);
}
DI void phase_groupnorm(const bf16_t* OA, const float* HS, const bf16_t* LG, const bf16_t* OC, const float* gg, bf16_t* ON, int nrows, const int WB) {
    const int lane = my_tid() & 63, wave = WB >> 6;
    const int gw = blockIdx.x * NWAVE + wave, NGW = gridDim.x * NWAVE;
    for (int r = gw; r < nrows; r += NGW) {
        float v[8];
        load8(OA + (size_t)r * 768 + (lane >> 3) * 96 + (lane & 7) * 8, v);
        group_out(v, gg + 8 * lane, ON + (size_t)r * 1536 + 8 * lane, lane);
        float lg[8]; load8(LG + (size_t)r * 512 + 8 * lane, lg);
        const f32x4 f0 = *(const f32x4*)(HS + (size_t)r * 512 + 8 * lane), f1 = *(const f32x4*)(HS + (size_t)r * 512 + 8 * lane + 4);
        const f32x4 b0 = *(const f32x4*)(HS + ((size_t)NTOK + r) * 512 + 8 * lane), b1 = *(const f32x4*)(HS + ((size_t)NTOK + r) * 512 + 8 * lane + 4);
#pragma unroll
        for (int e = 0; e < 4; ++e) { v[e] = (f0[e] + b0[e]) * gelu_tanh(lg[e]); v[4 + e] = (f1[e] + b1[e]) * gelu_tanh(lg[4 + e]); }
        group_out(v, gg + 512 + 8 * lane, ON + (size_t)r * 1536 + 512 + 8 * lane, lane);
        load8(OC + (size_t)r * 512 + 8 * lane, v);
        group_out(v, gg + 1024 + 8 * lane, ON + (size_t)r * 1536 + 1024 + 8 * lane, lane);
    }
}
struct AttnU { const bf16_t *Q, *KA, *KB, *VA, *VB; bf16_t* O; int qs, ks, vs, os, na, nb, kb0, q0, W; float sink; int has_sink; };
#define MFMA32(a, b, c) __builtin_amdgcn_mfma_f32_32x32x16_bf16((a), (b), (c), 0, 0, 0)
template <int DQ> DI void attn_unit(const AttnU& a, LAS unsigned char* L, int tid, const int WB) {
    constexpr int KSTR = DQ * 2 + 16, VSTR = 136, KBUF = 64 * KSTR, VBUF = 64 * VSTR, NS = DQ / 16, CPR = DQ / 8, NCH = 64 * CPR;
    const int lane = tid & 63, wave = WB >> 6, r = lane & 31, h = lane >> 5;
    bf16x8 qf[NS];
    { const bf16_t* qrow = a.Q + (size_t)(wave * 32 + r) * a.qs + 8 * h;
#pragma unroll
      for (int s = 0; s < NS; ++s) qf[s] = *(const bf16x8*)(qrow + 16 * s); }
    f32x16 o0, o1;
#pragma unroll
    for (int i = 0; i < 16; ++i) { o0[i] = 0.f; o1[i] = 0.f; }
    float m = a.has_sink ? a.sink : -1e30f, l = (a.has_sink && h == 0) ? 1.f : 0.f;
    const int nt = (a.na + a.nb) >> 6;
    const int c0r = tid / CPR, c0c = tid % CPR, c1r = (tid + 512) / CPR, c1c = (tid + 512) % CPR, vkey = tid >> 3, vc = tid & 7;
    u32x4 kreg0, kreg1 = {0u, 0u, 0u, 0u}, vreg;
    auto gload = [&](int t) {
        const int k0 = t * 64; const bf16_t* kp; const bf16_t* vp;
        if (k0 < a.na) { kp = a.KA + (size_t)k0 * a.ks; vp = a.VA + (size_t)k0 * a.vs; } else { kp = a.KB + (size_t)(k0 - a.na) * a.ks; vp = a.VB + (size_t)(k0 - a.na) * a.vs; }
        kreg0 = *(const u32x4*)(kp + (size_t)c0r * a.ks + c0c * 8);
        if (NCH > 512) { if (tid < NCH - 512) kreg1 = *(const u32x4*)(kp + (size_t)c1r * a.ks + c1c * 8); }
        vreg = *(const u32x4*)(vp + (size_t)vkey * a.vs + vc * 8);
    };
    auto lstore = [&](int buf) {
        *(LAS u32x4*)(L + buf * KBUF + c0r * KSTR + c0c * 16) = kreg0;
        if (NCH > 512) { if (tid < NCH - 512) *(LAS u32x4*)(L + buf * KBUF + c1r * KSTR + c1c * 16) = kreg1; }
        LAS unsigned char* vb = L + 2 * KBUF + buf * VBUF + (8 * vc) * VSTR + vkey * 2;
        *(LAS bf16_t*)(vb + 0 * VSTR) = (bf16_t)(vreg.x & 0xffffu); *(LAS bf16_t*)(vb + 1 * VSTR) = (bf16_t)(vreg.x >> 16);
        *(LAS bf16_t*)(vb + 2 * VSTR) = (bf16_t)(vreg.y & 0xffffu); *(LAS bf16_t*)(vb + 3 * VSTR) = (bf16_t)(vreg.y >> 16);
        *(LAS bf16_t*)(vb + 4 * VSTR) = (bf16_t)(vreg.z & 0xffffu); *(LAS bf16_t*)(vb + 5 * VSTR) = (bf16_t)(vreg.z >> 16);
        *(LAS bf16_t*)(vb + 6 * VSTR) = (bf16_t)(vreg.w & 0xffffu); *(LAS bf16_t*)(vb + 7 * VSTR) = (bf16_t)(vreg.w >> 16);
    };
    const int iq = a.q0 + wave * 32 + r, iq0 = a.q0 + wave * 32;
    gload(0);
    for (int t = 0; t < nt; ++t) {
        const int buf = t & 1;
        lstore(buf);
        __syncthreads();
        if (t + 1 < nt) gload(t + 1);
        const int k0 = t * 64; const bool masked = (k0 >= a.na) && (a.W < LSEQ); const int kpos0 = a.kb0 + (k0 - a.na);
        LAS unsigned char* Kb = L + buf * KBUF; LAS unsigned char* Vb = L + 2 * KBUF + buf * VBUF;
#pragma unroll
        for (int kh = 0; kh < 2; ++kh) {
            const int j0 = kpos0 + 32 * kh;
            if (masked && (j0 > iq0 + 31 + a.W || j0 + 31 < iq0 - a.W)) continue;
            f32x16 s;
#pragma unroll
            for (int i = 0; i < 16; ++i) s[i] = 0.f;
#pragma unroll
            for (int s_ = 0; s_ < NS; ++s_) { const bf16x8 kf = *(const LAS bf16x8*)(Kb + (32 * kh + r) * KSTR + (16 * s_ + 8 * h) * 2); s = MFMA32(kf, qf[s_], s); }
            if (masked) {
#pragma unroll
                for (int i = 0; i < 16; ++i) { const int j = j0 + (i & 3) + 8 * (i >> 2) + 4 * h; const int dlt = iq - j; if (dlt > a.W || dlt < -a.W) s[i] = -1e30f; }
            }
            float mx = s[0];
#pragma unroll
            for (int i = 1; i < 16; ++i) mx = fmaxf(mx, s[i]);
            mx = fmaxf(mx, SHX(mx, 32));
            const float mnew = fmaxf(m, mx); const float alpha = __builtin_amdgcn_exp2f(m - mnew); m = mnew;
            float ls = 0.f;
#pragma unroll
            for (int i = 0; i < 16; ++i) { s[i] = __builtin_amdgcn_exp2f(s[i] - mnew); ls += s[i]; }
            l = l * alpha + ls;
#pragma unroll
            for (int i = 0; i < 16; ++i) { o0[i] *= alpha; o1[i] *= alpha; }
            u32x4 pw0, pw1;
            pw0.x = cvtpk(s[0], s[1]); pw0.y = cvtpk(s[2], s[3]); pw0.z = cvtpk(s[4], s[5]); pw0.w = cvtpk(s[6], s[7]);
            pw1.x = cvtpk(s[8], s[9]); pw1.y = cvtpk(s[10], s[11]); pw1.z = cvtpk(s[12], s[13]); pw1.w = cvtpk(s[14], s[15]);
            const bf16x8 pf0 = __builtin_bit_cast(bf16x8, pw0), pf1 = __builtin_bit_cast(bf16x8, pw1);
#pragma unroll
            for (int s2 = 0; s2 < 2; ++s2) {
                const bf16x8 pf = s2 ? pf1 : pf0;
#pragma unroll
                for (int blk = 0; blk < 2; ++blk) {
                    const LAS unsigned char* va = Vb + (32 * blk + r) * VSTR + (32 * kh + 16 * s2 + 4 * h) * 2;
                    const s16x4 lo = *(const LAS s16x4*)va, hi = *(const LAS s16x4*)(va + 16);
                    const bf16x8 vf = __builtin_shufflevector(lo, hi, 0, 1, 2, 3, 4, 5, 6, 7);
                    if (blk == 0) o0 = MFMA32(vf, pf, o0); else o1 = MFMA32(vf, pf, o1);
                }
            }
        }
    }
    l += SHX(l, 32);
    const float inv = 1.f / l;
    bf16_t* orow = a.O + (size_t)(wave * 32 + r) * a.os;
#pragma unroll
    for (int g = 0; g < 4; ++g) {
        u32x2 w0, w1; w0.x = cvtpk(o0[4 * g] * inv, o0[4 * g + 1] * inv); w0.y = cvtpk(o0[4 * g + 2] * inv, o0[4 * g + 3] * inv);
        w1.x = cvtpk(o1[4 * g] * inv, o1[4 * g + 1] * inv); w1.y = cvtpk(o1[4 * g + 2] * inv, o1[4 * g + 3] * inv);
        *(u32x2*)(orow + 8 * g + 4 * h) = w0; *(u32x2*)(orow + 32 + 8 * g + 4 * h) = w1;
    }
    __syncthreads();
}
DI void phase_swa(bf16_t* SQ, const bf16_t* SK, const bf16_t* SV, const float* sinkp, bool with_ctx, LAS unsigned char* L, const int WB, bf16_t* OD = nullptr) {
    const int tid = my_tid(); const int nu = 1024 + (with_ctx ? 128 : 0);
    for (int u = blockIdx.x; u < nu; u += gridDim.x) {
        AttnU a; a.qs = 512; a.ks = 128; a.vs = 128; a.os = 512; a.W = 128; a.has_sink = 1;
        if (u < 1024) { const int qb = u & 7, hq = (u >> 3) & 7, b = u >> 6; const int kvh = hq >> 2; const int q0 = qb * 256;
            a.sink = sinkp[hq] * LOG2E; a.q0 = q0; a.kb0 = q0 - 128 < 0 ? 0 : q0 - 128; const int ke = q0 + 384 > LSEQ ? LSEQ : q0 + 384; a.nb = ke - a.kb0; a.na = NC;
            a.Q = SQ + (size_t)(b * LSEQ + q0) * 512 + hq * 64; a.O = SQ + (size_t)(b * LSEQ + q0) * 512 + hq * 64;
            a.KA = SK + (size_t)(NLAT + b * NC) * 128 + kvh * 64; a.VA = SV + (size_t)(NLAT + b * NC) * 128 + kvh * 64;
            a.KB = SK + (size_t)(b * LSEQ + a.kb0) * 128 + kvh * 64; a.VB = SV + (size_t)(b * LSEQ + a.kb0) * 128 + kvh * 64;
        } else { const int v = u - 1024; const int hq = v & 7, b = v >> 3; const int kvh = hq >> 2;
            a.sink = sinkp[hq] * LOG2E; a.q0 = 0; a.kb0 = 0; a.nb = 0; a.na = NC;
            a.Q = SQ + (size_t)(NLAT + b * NC) * 512 + hq * 64; a.O = SQ + (size_t)(NLAT + b * NC) * 512 + hq * 64;
            a.KA = SK + (size_t)(NLAT + b * NC) * 128 + kvh * 64; a.VA = SV + (size_t)(NLAT + b * NC) * 128 + kvh * 64; a.KB = a.KA; a.VB = a.VA;
        }
        if (OD) a.O = OD + (a.O - SQ);
        attn_unit<64>(a, L, tid, WB);
    }
}
DI void phase_mla(bf16_t* QR, const bf16_t* KVR, bool with_ctx, LAS unsigned char* L, const int WB, bf16_t* OD = nullptr) {
    const int tid = my_tid(); const int nu = 1024 + (with_ctx ? 128 : 0);
    for (int u = blockIdx.x; u < nu; u += gridDim.x) {
        AttnU a; a.qs = 768; a.ks = 1280; a.vs = 1280; a.os = 768; a.W = 1 << 20; a.has_sink = 0; a.sink = 0.f; a.q0 = 0; a.kb0 = 0; a.na = NC;
        if (u < 1024) { const int qb = u & 7, hh = (u >> 3) & 7, b = u >> 6;
            a.nb = LSEQ; a.Q = QR + (size_t)(b * LSEQ + qb * 256) * 768 + hh * 96; a.O = a.Q ? QR + (size_t)(b * LSEQ + qb * 256) * 768 + hh * 96 : nullptr;
            a.KA = KVR + (size_t)(NLAT + b * NC) * 1280 + hh * 160; a.KB = KVR + (size_t)(b * LSEQ) * 1280 + hh * 160;
        } else { const int v = u - 1024; const int hh = v & 7, b = v >> 3;
            a.nb = 0; a.Q = QR + (size_t)(NLAT + b * NC) * 768 + hh * 96; a.O = QR + (size_t)(NLAT + b * NC) * 768 + hh * 96;
            a.KA = KVR + (size_t)(NLAT + b * NC) * 1280 + hh * 160; a.KB = a.KA;
        }
        a.VA = a.KA + 96; a.VB = a.KB + 96;
        if (OD) a.O = OD + (a.O - QR);
        attn_unit<96>(a, L, tid, WB);
    }
}

struct Args { const float* in[27]; float* out; unsigned char* ws; int ph_lo, ph_hi; };
typedef const __attribute__((address_space(4))) Args* KArgs;
DI KArgs launder(KArgs p) { asm volatile("" : "+s"(p)); return p; }
#define WSP(T, off) ((T*)(A->ws + (off)))
#ifndef PROBE_MASK
#define PROBE_MASK 0
#endif
DI int opaque_i(int v) { asm volatile("" : "+s"(v)); return v; }
#define REPS(bit) for (int rep_ = 0, nrep_ = (((PROBE_MASK >> (bit)) & 1) ? opaque_i(2) : 1); rep_ < nrep_; ++rep_)
#define PHASE_BEGIN { const KArgs A = launder(ap0); {
#define PHASE_END   grid_bar(WSP(unsigned, 0), (++nbar) * gridDim.x, WB); } }
#define PHASE_END_LAST } }
#define LAYER_W(l) LayerW lw; lw.w_in = A->in[7] + (size_t)(l) * 1024 * 2208; lw.w_uq = A->in[9] + (size_t)(l) * 256 * 768; lw.w_ukv = A->in[11] + (size_t)(l) * 128 * 1024; \
        lw.gate_w = A->in[16] + (size_t)(l) * 2 * 2 * 8 * 64 * 64; lw.w_out = A->in[23] + (size_t)(l) * 1536 * 1024; lw.w_ff1 = A->in[25] + (size_t)(l) * 1024 * 4096; lw.w_ff2 = A->in[26] + (size_t)(l) * 4096 * 1024;
#define PHASE_END_MAYBE if (l == 0) grid_bar(WSP(unsigned, 0), (++nbar) * gridDim.x, WB); } }
DI void grid_bar(unsigned* ctr, unsigned target, const int WB) {
    asm volatile("s_waitcnt vmcnt(0)" ::: "memory");
    __syncthreads();
    if (my_tid() == 0) {
        __builtin_amdgcn_fence(__ATOMIC_RELEASE, "agent");
        asm volatile("s_waitcnt vmcnt(0)" ::: "memory");
        __hip_atomic_fetch_add(ctr, 1u, __ATOMIC_RELAXED, __HIP_MEMORY_SCOPE_AGENT);
        while (__hip_atomic_load(ctr, __ATOMIC_RELAXED, __HIP_MEMORY_SCOPE_AGENT) < target) __builtin_amdgcn_s_sleep(2);
        __builtin_amdgcn_fence(__ATOMIC_ACQUIRE, "agent");
        asm volatile("s_waitcnt vmcnt(0)" ::: "memory");
    }
    __syncthreads();
}
template <int l> DI void run_layer(const KArgs ap0, LAS unsigned char* L, unsigned& nbar, const int WB) {
        PHASE_BEGIN
            if (l == 1) { LAYER_W(1) phase_convert(lw, A->ws + WS_W, L, WB); }
            REPS(0) phase_norm(l == 0 ? A->in[0] : A->out, l == 0 ? A->in[2] : WSP(float, WS_XCRES), WSP(bf16_t, WS_HN), A->in[6] + l * 1024, WSP(float, WS_MOD) + (size_t)l * 17 * 6144, 0, NTOK, WB);
        PHASE_END
        PHASE_BEGIN
            pg8::Gemm g{WSP(bf16_t, WS_HN), WSP(bf16_t, WS_W + W_IN), NTOK, PW, 1024, 1024}; pg8::StaticOrder S; S.init(NTOK, PW, gridDim.x, blockIdx.x);
            pg8::EpiStore<0> E{WSP(bf16_t, WS_P), PW};
            REPS(1) pg8::gemm_phase<pg8::EpiStore<0>, pg8::StaticOrder, true, true>(L, g, S, E, WB);
        PHASE_END
        PHASE_BEGIN
            PrepW pw{A->in[8] + l * 256, A->in[10] + l * 128, A->in[14] + l * 4 * 512, A->in[15] + l * 512, A->in[19] + l * 64, A->in[20] + l * 64};
#ifndef SK_PREP
            REPS(2) phase_prep(WSP(bf16_t, WS_P), pw, WSP(bf16_t, WS_CQN), WSP(bf16_t, WS_CKVN), WSP(bf16_t, WS_KR), WSP(bf16_t, WS_XC), WSP(bf16_t, WS_LG), WSP(bf16_t, WS_SQ), WSP(bf16_t, WS_SK), WSP(bf16_t, WS_SV), WB);
#endif
        PHASE_END
        PHASE_BEGIN
            const int mrows = l == 1 ? NLAT : NTOK;
            { pg8::Gemm g{WSP(bf16_t, WS_CQN), WSP(bf16_t, WS_W + W_UQ), mrows, 768, 256, 256}; pg8::StaticOrder S; S.init(mrows, 768, gridDim.x, blockIdx.x);
              pg8::EpiStore<0> E{WSP(bf16_t, WS_QR), 768}; REPS(3) pg8::gemm_phase<pg8::EpiStore<0>, pg8::StaticOrder, true, true>(L, g, S, E, WB); }
            { pg8::Gemm g{WSP(bf16_t, WS_CKVN), WSP(bf16_t, WS_W + W_UKV), NTOK, 1280, 128, 128}; pg8::StaticOrder S; S.init(NTOK, 1280, gridDim.x, blockIdx.x);
              pg8::EpiStore<0> E{WSP(bf16_t, WS_KVR), 1280}; REPS(3) pg8::gemm_phase<pg8::EpiStore<0>, pg8::StaticOrder, true, true>(L, g, S, E, WB); }
#ifndef SK_GATE
#pragma unroll 1
            for (int j = 0; j < 4; ++j) { pg8::Gemm g{WSP(bf16_t, WS_XC) + 128 * j, WSP(bf16_t, WS_W + W_G) + (size_t)j * 512 * 128, NTOK, 512, 128, 512}; pg8::StaticOrder S; S.init(NTOK, 512, gridDim.x, blockIdx.x);
              pg8::EpiGate E{WSP(bf16_t, WS_XC), WSP(unsigned, WS_AU), A->in[17] + l * 2048, A->in[18] + l * 1024, j, NTOK}; REPS(3) pg8::gemm_phase<pg8::EpiGate, pg8::StaticOrder, true, false>(L, g, S, E, WB); }
#endif
        PHASE_END
        PHASE_BEGIN
            FinW fw{A->in[12] + l * 96, A->in[13] + l * 96};
#ifndef SK_FIN
            phase_finish(WSP(bf16_t, WS_QR), WSP(bf16_t, WS_KVR), WSP(bf16_t, WS_KR), fw, l == 1 ? NLAT : NTOK, WB);
#endif
#ifndef SK_SCAN
            phase_scan(WSP(unsigned, WS_AU), L, WB);
#endif
#ifndef SK_ATTN
            REPS(7) phase_swa(WSP(bf16_t, WS_SQ), WSP(bf16_t, WS_SK), WSP(bf16_t, WS_SV), A->in[21] + l * 8, l == 0, L, WB, (((PROBE_MASK >> 7) & 1) && rep_ == 0) ? WSP(bf16_t, WS_CQN) : nullptr);
#endif
        PHASE_END
        PHASE_BEGIN
#ifndef SK_ATTN
            REPS(8) phase_mla(WSP(bf16_t, WS_QR), WSP(bf16_t, WS_KVR), l == 0, L, WB, (((PROBE_MASK >> 8) & 1) && rep_ == 0) ? WSP(bf16_t, WS_CQN) : nullptr);
#endif
        PHASE_END
        PHASE_BEGIN
            REPS(4) phase_groupnorm(WSP(bf16_t, WS_QR), WSP(float, WS_AU), WSP(bf16_t, WS_LG), WSP(bf16_t, WS_SQ), A->in[22] + l * 1536, WSP(bf16_t, WS_ON), l == 1 ? NLAT : NTOK, WB);
        PHASE_END
        PHASE_BEGIN
            const int mrows = l == 1 ? NLAT : NTOK;
            pg8::Gemm g{WSP(bf16_t, WS_ON), WSP(bf16_t, WS_W + W_OUT), mrows, 1024, 1536, 1536}; pg8::StaticOrder S; S.init(mrows, 1024, gridDim.x, blockIdx.x);
            pg8::EpiResid E{l == 0 ? A->in[0] : A->out, l == 0 ? A->in[2] : WSP(float, WS_XCRES), A->out, WSP(float, WS_XCRES), WSP(float, WS_MOD) + (size_t)l * 17 * 6144 + 2 * 1024};
#ifndef SK_RESID
            pg8::gemm_phase<pg8::EpiResid, pg8::StaticOrder, true, true>(L, g, S, E, WB);
#endif
        PHASE_END
        PHASE_BEGIN
            REPS(5) phase_norm(A->out, WSP(float, WS_XCRES), WSP(bf16_t, WS_HN), A->in[24] + l * 1024, WSP(float, WS_MOD) + (size_t)l * 17 * 6144, 3, l == 1 ? NLAT : NTOK, WB);
        PHASE_END
        PHASE_BEGIN
            const int mrows = l == 1 ? NLAT : NTOK;
            pg8::Gemm g{WSP(bf16_t, WS_HN), WSP(bf16_t, WS_W + W_FF1), mrows, 4096, 1024, 1024}; pg8::StaticOrder S; S.init(mrows, 4096, gridDim.x, blockIdx.x);
            pg8::EpiStore<2> E{WSP(bf16_t, WS_H), 4096}; REPS(6) pg8::gemm_phase<pg8::EpiStore<2>, pg8::StaticOrder, true, true>(L, g, S, E, WB);
        PHASE_END
        PHASE_BEGIN
            const int mrows = l == 1 ? NLAT : NTOK;
            pg8::Gemm g{WSP(bf16_t, WS_H), WSP(bf16_t, WS_W + W_FF2), mrows, 1024, 4096, 4096}; pg8::StaticOrder S; S.init(mrows, 1024, gridDim.x, blockIdx.x);
            pg8::EpiResid E{A->out, WSP(float, WS_XCRES), A->out, WSP(float, WS_XCRES), WSP(float, WS_MOD) + (size_t)l * 17 * 6144 + 5 * 1024};
#ifndef SK_RESID
            pg8::gemm_phase<pg8::EpiResid, pg8::StaticOrder, true, true>(L, g, S, E, WB);
#endif
        PHASE_END_MAYBE
}
__global__ void __launch_bounds__(NTHR, 2) fwd_megakernel(Args args_by_value) {
    extern __shared__ __attribute__((aligned(16))) unsigned char lds_raw[];
    LAS unsigned char* L = (LAS unsigned char*)lds_raw;
    cg::grid_group grid = cg::this_grid();
    const KArgs ap0 = (KArgs)__builtin_amdgcn_kernarg_segment_ptr();
    grid.sync();
    const int WB = __builtin_amdgcn_readfirstlane(threadIdx.x);
    unsigned nbar = 0;
    PHASE_BEGIN
#ifndef SK_MOD
        phase_mod(A->in[1], A->in[3], A->in[4], A->in[5], WSP(float, WS_MOD), L, WB);
#endif
        __syncthreads();
        LAYER_W(0)
        phase_convert(lw, A->ws + WS_W, L, WB);
    PHASE_END
    run_layer<0>(ap0, L, nbar, WB);
    run_layer<1>(ap0, L, nbar, WB);
}
constexpr int N_PHASES = 23;

extern "C" void kernel_launch(void* const* d_in, const int* in_sizes, int n_in, void* d_out, int out_size, void* d_ws, size_t ws_size, hipStream_t stream) {
    static int grid = 0;
    if (grid == 0) {
        if (n_in != 27 || ws_size < WS_END) { fprintf(stderr, "kernel_launch: unexpected n_in %d / ws_size %zu\n", n_in, ws_size); grid = -1; return; }
        int dev = 0, cus = 0, per_cu = 0;
        hipGetDevice(&dev); hipDeviceGetAttribute(&cus, hipDeviceAttributeMultiprocessorCount, dev);
        if (hipFuncSetAttribute((const void*)fwd_megakernel, hipFuncAttributeMaxDynamicSharedMemorySize, LDS_BYTES) != hipSuccess) { fprintf(stderr, "kernel_launch: hipFuncSetAttribute failed\n"); grid = -1; return; }
        if (hipOccupancyMaxActiveBlocksPerMultiprocessor(&per_cu, (const void*)fwd_megakernel, NTHR, LDS_BYTES) != hipSuccess || per_cu < 1) { fprintf(stderr, "kernel_launch: occupancy query says %d\n", per_cu); per_cu = 1; }
        (void)hipGetLastError();
        grid = cus;
        if (grid != 256) { fprintf(stderr, "kernel_launch: needs a 256-CU device (got %d)\n", grid); grid = -1; return; }
    }
    if (grid < 0) return;
    if (hipMemsetAsync(d_ws, 0, 256, stream) != hipSuccess) { fprintf(stderr, "memset failed\n"); return; }
    Args a{};
    for (int i = 0; i < 27; ++i) a.in[i] = (const float*)d_in[i];
    a.out = (float*)d_out; a.ws = (unsigned char*)d_ws; a.ph_lo = 0; a.ph_hi = N_PHASES;
    void* kargs[] = {&a};
    hipError_t e = hipLaunchCooperativeKernel((const void*)fwd_megakernel, dim3(grid), dim3(NTHR), kargs, LDS_BYTES, stream);
    if (e != hipSuccess) fprintf(stderr, "cooperative launch failed: %s (grid %d)\n", hipGetErrorString(e), grid);
}
```

```cpp
#include <hip/hip_runtime.h>
#include <hip/hip_cooperative_groups.h>
#include <cstdio>
#include <cstdint>
namespace cg = cooperative_groups;
namespace pg8 {
#define PG8_LAS __attribute__((address_space(3)))
typedef unsigned short bf16_t;
typedef short bf16x8 __attribute__((ext_vector_type(8)));
typedef float f32x4 __attribute__((ext_vector_type(4)));
typedef unsigned u32x4 __attribute__((ext_vector_type(4)));
constexpr int BM = 256, BK = 64, HALF = 128, HTB = HALF * BK * 2  , STAGE_BYTES = 8 * HTB, NXCD = 8, WGM = 8;

__host__ __device__ __forceinline__ int lds_byte(int r, int c) { const int st = (r >> 4) * 2 + (c >> 5), rr = r & 15, cc = c & 31, ob = rr * 64 + cc * 2; return st * 1024 + (ob ^ (((ob >> 9) & 1) << 5)); }
__host__ __device__ __forceinline__ void stage_rc(int b, int& R, int& C) { const int st = b / 1024, sb = b % 1024, swz = sb ^ (((sb >> 9) & 1) << 5); R = (st >> 1) * 16 + swz / 64; C = (st & 1) * 32 + (swz % 64) / 2; }
__host__ __device__ __forceinline__ int perm32(int rho) { const int n = rho >> 4, i = rho & 15; return 8 * (i >> 2) + 4 * n + (i & 3); }

struct Unit { int pm, pn, aoff, nt; };
struct Gemm { const bf16_t* A; const bf16_t* Bt; int M, N, K, lda; };

struct StaticOrder {
    int nM, nN, nwg, G, c;
    __host__ __device__ void init(int M, int N, int G_, int c_) { nM = M / BM; nN = N / BM; nwg = nM * nN; G = G_; c = c_; }
    __host__ __device__ bool next(int i, Unit& u) const {
        const long L = (long)i * G + c; if (L >= nwg) return false;
        int wgid = (int)L; { const int q = nwg / NXCD, r = nwg % NXCD, xcd = wgid % NXCD, off = wgid / NXCD; wgid = (xcd < r ? xcd * (q + 1) : r * (q + 1) + (xcd - r) * q) + off; }
        const int nig = WGM * nN, gid = wgid / nig, fm = gid * WGM, gsz = (nM - fm) < WGM ? (nM - fm) : WGM;
        u.pm = fm + ((wgid % nig) % gsz); u.pn = (wgid % nig) / gsz; u.aoff = 0; u.nt = 0; return true;
    }
    __device__ __forceinline__ void a_ready(const Unit&) const {}
    __device__ __forceinline__ void done(const Unit&) const {}
};

__device__ __forceinline__ unsigned cvt_pk_bf16(float lo, float hi) { unsigned r; asm volatile("v_cvt_pk_bf16_f32 %0, %1, %2" : "=v"(r) : "v"(lo), "v"(hi)); return r; }
typedef float f32x2 __attribute__((ext_vector_type(2)));
template <class Epi, class Sched, bool ALIGN_EPI = false, bool SP2 = false>
__device__ __forceinline__ void gemm_phase(PG8_LAS unsigned char* lds, const Gemm g, const Sched& S, const Epi& E, const int WB) {
    int tid_l; asm volatile("v_mbcnt_lo_u32_b32 %0, -1, 0\n\tv_mbcnt_hi_u32_b32 %0, -1, %0\n\tv_add_u32_e32 %0, %1, %0" : "=&v"(tid_l) : "s"(WB)); const int tid = tid_l, wid = __builtin_amdgcn_readfirstlane(tid >> 6), lane = tid & 63, wr = wid >> 2, wc = wid & 3, fr = lane & 15, fq = lane >> 4;
    const int K = g.K, nt_full = K / BK;
    unsigned voffA[2], voffB[2];
#pragma unroll
    for (int i = 0; i < 2; ++i) { int R, C; stage_rc(tid * 16 + i * 8192, R, C); const int Rb = Epi::PERM ? ((R & ~31) + perm32(R & 31)) : R;
        voffA[i] = (unsigned)(R * g.lda + C) * 2u; voffB[i] = (unsigned)(Rb * K + C) * 2u; }
    const size_t kstep = (size_t)(BK * 2);
    const size_t hstepA = (size_t)HALF * g.lda * 2, hstepB = (size_t)HALF * K * 2;
    const size_t tstepA = 2 * hstepA, tstepB = 2 * hstepB;
    const unsigned ldsw = (unsigned)wid * 1024u;
    const int aoff = lds_byte(wr * 64 + fr, fq * 8), boff = lds_byte(wc * 32 + fr, fq * 8);
#define PG8_SA(b, h) (((b) * 2 + (h)) * HTB)
#define PG8_SB(b, h) ((4 + (b) * 2 + (h)) * HTB)
#define PG8_STAGE(bufoff, gbase, voff) do { _Pragma("unroll") for (int _i = 0; _i < 2; ++_i) \
        __builtin_amdgcn_global_load_lds((const unsigned*)((const char*)(gbase) + (voff)[_i]), (PG8_LAS unsigned*)(lds + (bufoff) + ldsw + _i * 8192), 16, 0, 0); } while (0)
#define PG8_LDA(dst, b, h) do { _Pragma("unroll") for (int m = 0; m < 4; ++m) _Pragma("unroll") for (int k = 0; k < 2; ++k) dst[m][k] = *(const PG8_LAS bf16x8*)(lds + PG8_SA(b, h) + aoff + m * 2048 + k * 1024); } while (0)
#define PG8_LDB(dst, b, h) do { _Pragma("unroll") for (int n = 0; n < 2; ++n) _Pragma("unroll") for (int k = 0; k < 2; ++k) dst[n][k] = *(const PG8_LAS bf16x8*)(lds + PG8_SB(b, h) + boff + n * 2048 + k * 1024); } while (0)
#define PG8_MMA(ai, bj, At, Bt) do { __builtin_amdgcn_s_setprio(1); _Pragma("unroll") for (int m = 0; m < 4; ++m) _Pragma("unroll") for (int n = 0; n < 2; ++n) _Pragma("unroll") for (int k = 0; k < 2; ++k) \
        acc[ai][bj][m][n] = __builtin_amdgcn_mfma_f32_16x16x32_bf16(Bt[n][k], At[m][k], acc[ai][bj][m][n], 0, 0, 0); __builtin_amdgcn_s_setprio(0); } while (0)
#define PG8_WAIT_V(n) asm volatile("s_waitcnt vmcnt(" #n ")" ::: "memory")
#define PG8_WAIT_L(n) asm volatile("s_waitcnt lgkmcnt(" #n ")" ::: "memory")
#define PG8_BAR __builtin_amdgcn_s_barrier()
#define PG8_SCHED __builtin_amdgcn_sched_barrier(0)
    Unit cur, nxt; int ui = 0;
    if (!S.next(0, cur)) return;
    f32x4 acc[2][2][4][2];
#pragma unroll
    for (int a = 0; a < 2; ++a)
#pragma unroll
        for (int b = 0; b < 2; ++b)
#pragma unroll
            for (int m = 0; m < 4; ++m)
#pragma unroll
                for (int n = 0; n < 2; ++n) acc[a][b][m][n] = (f32x4){0.f, 0.f, 0.f, 0.f};
    bf16x8 At[4][2], B0[2][2], B1[2][2];
    const char* cA = (const char*)g.A + (size_t)cur.pm * tstepA + cur.aoff; const char* cB = (const char*)g.Bt + (size_t)cur.pn * tstepB;
    S.a_ready(cur);
    if constexpr (SP2) {
        PG8_STAGE(PG8_SB(0, 0), cB, voffB); PG8_STAGE(PG8_SB(0, 1), cB + hstepB, voffB); PG8_STAGE(PG8_SA(0, 0), cA, voffA); PG8_STAGE(PG8_SA(0, 1), cA + hstepA, voffA);
        if (wr == 1) PG8_BAR;
        PG8_WAIT_V(2); PG8_BAR;
        PG8_STAGE(PG8_SB(1, 0), cB + kstep, voffB); PG8_STAGE(PG8_SA(1, 0), cA + kstep, voffA); PG8_STAGE(PG8_SB(1, 1), cB + hstepB + kstep, voffB);
        PG8_WAIT_V(6); PG8_BAR;
    } else {
        PG8_STAGE(PG8_SB(0, 0), cB, voffB); PG8_STAGE(PG8_SA(0, 0), cA, voffA); PG8_STAGE(PG8_SB(0, 1), cB + hstepB, voffB); PG8_STAGE(PG8_SA(0, 1), cA + hstepA, voffA);
        if (wr == 1) PG8_BAR;
        PG8_WAIT_V(4); PG8_BAR;
        PG8_STAGE(PG8_SB(1, 0), cB + kstep, voffB); PG8_STAGE(PG8_SA(1, 0), cA + kstep, voffA); PG8_STAGE(PG8_SB(1, 1), cB + hstepB + kstep, voffB);
        PG8_WAIT_V(6); PG8_BAR;
    }
    for (;;) {
        const bool has_next = S.next(ui + 1, nxt);
        const int nt = cur.nt ? cur.nt : nt_full;
        const char* nA = has_next ? (const char*)g.A + (size_t)nxt.pm * tstepA + nxt.aoff : cA; const char* nB = has_next ? (const char*)g.Bt + (size_t)nxt.pn * tstepB : cB;
        for (int t = 0; t < nt; t += 2) {
            const bool last = (t == nt - 2);
            const char* a1 = cA + (size_t)(t + 1) * kstep;
            const char* a2 = last ? nA : cA + (size_t)(t + 2) * kstep; const char* b2 = last ? nB : cB + (size_t)(t + 2) * kstep;
            const char* a3 = a2 + kstep; const char* b3 = b2 + kstep;
            if (last && has_next) S.a_ready(nxt);
            if constexpr (SP2) {
            PG8_LDB(B0, 0, 0); PG8_LDB(B1, 0, 1); PG8_SCHED; PG8_LDA(At, 0, 0); PG8_STAGE(PG8_SA(1, 1), a1 + hstepA, voffA);
            PG8_WAIT_V(8); PG8_WAIT_L(0); PG8_BAR; PG8_MMA(0, 0, At, B0); PG8_MMA(0, 1, At, B1); PG8_BAR; PG8_SCHED;
            PG8_LDA(At, 0, 1); PG8_STAGE(PG8_SB(0, 0), b2, voffB); PG8_STAGE(PG8_SB(0, 1), b2 + hstepB, voffB); PG8_STAGE(PG8_SA(0, 0), a2, voffA);
            PG8_WAIT_V(8); PG8_WAIT_L(0); PG8_BAR; PG8_MMA(1, 0, At, B0); PG8_MMA(1, 1, At, B1); PG8_BAR; PG8_SCHED;
            PG8_LDB(B0, 1, 0); PG8_LDB(B1, 1, 1); PG8_SCHED; PG8_LDA(At, 1, 0); PG8_STAGE(PG8_SA(0, 1), a2 + hstepA, voffA);
            PG8_WAIT_V(8); PG8_WAIT_L(0); PG8_BAR; PG8_MMA(0, 0, At, B0); PG8_MMA(0, 1, At, B1); PG8_BAR; PG8_SCHED;
            PG8_LDA(At, 1, 1); PG8_STAGE(PG8_SB(1, 0), b3, voffB); PG8_STAGE(PG8_SB(1, 1), b3 + hstepB, voffB); PG8_STAGE(PG8_SA(1, 0), a3, voffA);
            PG8_WAIT_V(8); PG8_WAIT_L(0); PG8_BAR; PG8_MMA(1, 0, At, B0); PG8_MMA(1, 1, At, B1); PG8_BAR; PG8_SCHED;
            } else {
            PG8_LDB(B0, 0, 0); PG8_SCHED; PG8_LDA(At, 0, 0); PG8_STAGE(PG8_SA(1, 1), a1 + hstepA, voffA);
            PG8_WAIT_L(8); PG8_BAR; PG8_WAIT_L(0); PG8_MMA(0, 0, At, B0); PG8_BAR; PG8_SCHED;
            PG8_LDB(B1, 0, 1); PG8_STAGE(PG8_SB(0, 0), b2, voffB);
            PG8_BAR; PG8_WAIT_L(0); PG8_MMA(0, 1, At, B1); PG8_BAR;
            PG8_LDA(At, 0, 1); PG8_STAGE(PG8_SA(0, 0), a2, voffA);
            PG8_BAR; PG8_WAIT_L(0); PG8_MMA(1, 0, At, B0); PG8_BAR; PG8_SCHED;
            PG8_STAGE(PG8_SB(0, 1), b2 + hstepB, voffB);
            PG8_WAIT_V(6); PG8_BAR; PG8_MMA(1, 1, At, B1); PG8_BAR;
            PG8_LDB(B0, 1, 0); PG8_SCHED; PG8_LDA(At, 1, 0); PG8_STAGE(PG8_SA(0, 1), a2 + hstepA, voffA);
            PG8_WAIT_L(8); PG8_BAR; PG8_WAIT_L(0); PG8_MMA(0, 0, At, B0); PG8_BAR; PG8_SCHED;
            PG8_LDB(B1, 1, 1); PG8_STAGE(PG8_SB(1, 0), b3, voffB);
            PG8_BAR; PG8_WAIT_L(0); PG8_MMA(0, 1, At, B1); PG8_BAR;
            PG8_LDA(At, 1, 1); PG8_STAGE(PG8_SA(1, 0), a3, voffA);
            PG8_BAR; PG8_WAIT_L(0); PG8_MMA(1, 0, At, B0); PG8_BAR; PG8_SCHED;
            PG8_STAGE(PG8_SB(1, 1), b3 + hstepB, voffB);
            PG8_WAIT_V(6); PG8_BAR; PG8_MMA(1, 1, At, B1); PG8_BAR;
            }
        }
        if constexpr (ALIGN_EPI) { if (wr == 0) PG8_BAR; }
        if constexpr (!Epi::AFTER_DRAIN) { E(acc, cur, wr, wc, fr, fq); S.done(cur); }
        if (!has_next) break;
#pragma unroll
        for (int a = 0; a < 2; ++a)
#pragma unroll
            for (int b = 0; b < 2; ++b)
#pragma unroll
                for (int m = 0; m < 4; ++m)
#pragma unroll
                    for (int n = 0; n < 2; ++n) acc[a][b][m][n] = (f32x4){0.f, 0.f, 0.f, 0.f};
        cur = nxt; cA = nA; cB = nB; ++ui;
        if constexpr (ALIGN_EPI) { if (wr == 1) PG8_BAR; }
    }
    PG8_WAIT_V(0);
    if constexpr (!ALIGN_EPI) { if (wr == 0) PG8_BAR; }
    PG8_BAR;
    if constexpr (Epi::AFTER_DRAIN) { E.fused(acc, cur, wr, wc, fr, fq, lds, wid, lane); S.done(cur); }
#undef PG8_SA
#undef PG8_SB
#undef PG8_STAGE
#undef PG8_LDA
#undef PG8_LDB
#undef PG8_MMA
#undef PG8_WAIT_V
#undef PG8_WAIT_L
#undef PG8_BAR
#undef PG8_SCHED
}
}
namespace pg8 {
typedef unsigned u32x2v __attribute__((ext_vector_type(2)));
template <bool LAST> struct WinOrder { StaticOrder so; int G, c;
    __host__ __device__ void init(int G_, int c_) { so.init(LAST ? 32768 : 36864, 2304, G_, c_); G = G_; c = c_; }
    __host__ __device__ bool next(int i, Unit& u) const {
        if (!LAST) return so.next(i, u);
        const long L = (long)i * G + c; if (L >= 1280) return false;
        if (L < 1152) return so.next(i, u);
        const int idx = (int)L - 1152; u.pm = 128 + (idx & 15); u.pn = 1 + (idx >> 4); u.aoff = 0; u.nt = 0; return true; }
    __device__ __forceinline__ void a_ready(const Unit&) const {}
    __device__ __forceinline__ void done(const Unit&) const {}
};
struct S4Order { StaticOrder so;
    __host__ __device__ void init(int M, int N, int G_, int c_) { so.init(M, N, G_, c_); }
    __host__ __device__ bool next(int i, Unit& u) const { if (!so.next(i, u)) return false; u.aoff = u.pn < 3 ? 0 : (u.pn < 8 ? 512 : (1024 + 256 * ((u.pn - 8) >> 1))); u.nt = u.pn < 3 ? 0 : 2; return true; }
    __device__ __forceinline__ void a_ready(const Unit&) const {}
    __device__ __forceinline__ void done(const Unit&) const {}
};
template <int ACT> struct EpiStore {
    static constexpr bool PERM = true, AFTER_DRAIN = false;
    bf16_t* O; int ldc; long long d2 = 0; int ldc2 = 0, t0 = 0, t1 = 0; long long d3 = 0; int t2 = 0, t3 = 0;
    __device__ __forceinline__ void operator()(const f32x4 (&acc)[2][2][4][2], const Unit& u, int wr, int wc, int fr, int fq) const {
        const bool alt2 = u.pn >= t0 && u.pn < t1, alt3 = u.pn >= t2 && u.pn < t3, alt = alt2 || alt3; const long long dd = alt2 ? d2 : (alt3 ? d3 : 0ll); bf16_t* O = this->O + dd; const int ldc = alt ? ldc2 : this->ldc;
        const int row0 = u.pm * BM + wr * 64 + fr; const int col0 = (alt2 ? u.pn - t0 : (alt3 ? u.pn - t2 : u.pn)) * BM + wc * 32 + 8 * fq;
#pragma unroll
        for (int ai = 0; ai < 2; ++ai)
#pragma unroll
            for (int m = 0; m < 4; ++m) { bf16_t* rowp = O + (size_t)(row0 + ai * HALF + m * 16) * ldc + col0;
#pragma unroll
                for (int bj = 0; bj < 2; ++bj) { f32x4 v0 = acc[ai][bj][m][0], v1 = acc[ai][bj][m][1];
                    if (ACT == 2) {
#pragma unroll
                        for (int e = 0; e < 4; ++e) { float a = fmaxf(v0[e], 0.f), b = fmaxf(v1[e], 0.f); v0[e] = a * a; v1[e] = b * b; } }
                    u32x4 w; w.x = cvt_pk_bf16(v0[0], v0[1]); w.y = cvt_pk_bf16(v0[2], v0[3]); w.z = cvt_pk_bf16(v1[0], v1[1]); w.w = cvt_pk_bf16(v1[2], v1[3]);
                    *(u32x4*)(rowp + bj * HALF) = w; } }
    }
};
struct EpiDelta {
    static constexpr bool PERM = true, AFTER_DRAIN = false;
    bf16_t* Y; const float* gate;
    __device__ __forceinline__ void operator()(const f32x4 (&acc)[2][2][4][2], const Unit& u, int wr, int wc, int fr, int fq) const {
        const int mr = u.pm < 128 ? (u.pm >> 3) : 16;
        const int row0 = u.pm * BM + wr * 64 + fr; const int col0 = u.pn * BM + wc * 32 + 8 * fq;
        const float* gp = gate + (size_t)mr * 6144 + col0;
        f32x4 g0[2], g1[2];
#pragma unroll
        for (int bj = 0; bj < 2; ++bj) { g0[bj] = *(const f32x4*)(gp + bj * HALF); g1[bj] = *(const f32x4*)(gp + bj * HALF + 4); }
#pragma unroll
        for (int ai = 0; ai < 2; ++ai)
#pragma unroll
            for (int m = 0; m < 4; ++m) { bf16_t* rowp = Y + (size_t)(row0 + ai * HALF + m * 16) * 1024 + col0;
#pragma unroll
                for (int bj = 0; bj < 2; ++bj) { const f32x4 v0 = acc[ai][bj][m][0] * g0[bj], v1 = acc[ai][bj][m][1] * g1[bj];
                    u32x4 w; w.x = cvt_pk_bf16(v0[0], v0[1]); w.y = cvt_pk_bf16(v0[2], v0[3]); w.z = cvt_pk_bf16(v1[0], v1[1]); w.w = cvt_pk_bf16(v1[2], v1[3]);
                    *(u32x4*)(rowp + bj * HALF) = w; } }
    }
};
struct EpiResid {
    static constexpr bool PERM = false, AFTER_DRAIN = false;
    const float* res_lat; const float* res_ctx; float* out_lat; float* out_ctx; const float* gate;
    __device__ __forceinline__ void operator()(const f32x4 (&acc)[2][2][4][2], const Unit& u, int wr, int wc, int fr, int fq) const {
        const bool lat = u.pm < 128; const int mr = lat ? (u.pm >> 3) : 16;
        const float* rb = lat ? res_lat + (size_t)u.pm * BM * 1024 : res_ctx + (size_t)(u.pm - 128) * BM * 1024;
        float* ob = lat ? out_lat + (size_t)u.pm * BM * 1024 : out_ctx + (size_t)(u.pm - 128) * BM * 1024;
        const float* gp = gate + (size_t)mr * 6144;
#pragma unroll
        for (int bj = 0; bj < 2; ++bj)
#pragma unroll
            for (int n = 0; n < 2; ++n) { const int col = u.pn * BM + bj * HALF + wc * 32 + n * 16 + 4 * fq; const f32x4 g = *(const f32x4*)(gp + col);
#pragma unroll
                for (int ai = 0; ai < 2; ++ai)
#pragma unroll
                    for (int m = 0; m < 4; ++m) { const size_t off = (size_t)(ai * HALF + wr * 64 + m * 16 + fr) * 1024 + col;
                        const f32x4 r = *(const f32x4*)(rb + off); *(f32x4*)(ob + off) = r + g * acc[ai][bj][m][n]; } }
    }
};
struct EpiGate {
    static constexpr bool PERM = false, AFTER_DRAIN = false;
    const bf16_t* XC; unsigned* AU; const float* gb; const float* lam; int ntok;
    __device__ __forceinline__ void operator()(const f32x4 (&acc)[2][2][4][2], const Unit& u, int wr, int wc, int fr, int fq) const {
        const int ch = 64 * (u.pn - 8) + 16 * wc + 4 * fq;
#pragma unroll
        for (int z = 0; z < 2; ++z) {
            const f32x4 br = *(const f32x4*)(gb + z * 1024 + ch), bi = *(const f32x4*)(gb + z * 1024 + 512 + ch);
            const f32x4 lm = *(const f32x4*)(lam + z * 512 + ch);
            f32x4 sp;
#pragma unroll
            for (int i = 0; i < 4; ++i) sp[i] = __logf(1.f + __expf(-lm[i])) * (-8.f * 1.4426950408889634f);
#pragma unroll
            for (int ai = 0; ai < 2; ++ai)
#pragma unroll
                for (int m = 0; m < 4; ++m) { const int row = u.pm * BM + ai * HALF + wr * 64 + m * 16 + fr;
                    const unsigned o = (unsigned)row * 512u + (unsigned)ch;
                    const u32x2v xw = *(const u32x2v*)(XC + (unsigned)row * 1024u + (unsigned)ch);
                    float x[4]; x[0] = __uint_as_float(xw.x << 16); x[1] = __uint_as_float(xw.x & 0xffff0000u); x[2] = __uint_as_float(xw.y << 16); x[3] = __uint_as_float(xw.y & 0xffff0000u);
                    const f32x4 vr = acc[ai][z][m][0], vi = acc[ai][z][m][1];
                    u32x4 ov;
#pragma unroll
                    for (int i = 0; i < 4; ++i) {
                        const float rr = __builtin_amdgcn_rcpf(1.f + __expf(-(vr[i] + br[i]))), jj = __builtin_amdgcn_rcpf(1.f + __expf(-(vi[i] + bi[i])));
                        const float la = rr * sp[i];
                        const float uu = __builtin_amdgcn_sqrtf(fmaxf(1.f - __builtin_amdgcn_exp2f(2.f * la), 0.f)) * jj * x[i];
                        ov[i] = cvt_pk_bf16(la, uu); }
                    *(u32x4*)(AU + o + (unsigned)(z * ntok) * 512u) = ov; }
        }
    }
};
struct EpiS4 {
    static constexpr bool PERM = false, AFTER_DRAIN = false;
    bf16_t* QR; bf16_t* KVR; EpiGate G; int q_rows;
    __device__ __forceinline__ void operator()(const f32x4 (&acc)[2][2][4][2], const Unit& u, int wr, int wc, int fr, int fq) const {
        asm volatile("" : "+v"(fr), "+v"(fq));
        if (u.pn >= 8) { G(acc, u, wr, wc, fr, fq); return; }
        const bool isq = u.pn < 3; if (isq && u.pm * BM >= q_rows) return;
        bf16_t* O = isq ? QR : KVR; const int ldc = isq ? 768 : 1280; const int ct = isq ? u.pn : u.pn - 3;
#pragma unroll
        for (int ai = 0; ai < 2; ++ai)
#pragma unroll
            for (int m = 0; m < 4; ++m) { bf16_t* rowp = O + (size_t)(u.pm * BM + ai * HALF + wr * 64 + m * 16 + fr) * ldc + ct * BM + wc * 32 + 4 * fq;
#pragma unroll
                for (int bj = 0; bj < 2; ++bj)
#pragma unroll
                    for (int n = 0; n < 2; ++n) { const f32x4 v = acc[ai][bj][m][n]; u32x2v w; w.x = cvt_pk_bf16(v[0], v[1]); w.y = cvt_pk_bf16(v[2], v[3]); *(u32x2v*)(rowp + bj * HALF + n * 16) = w; } }
    }
};
}
#define DI __device__ __forceinline__
#define LAS __attribute__((address_space(3)))
typedef unsigned short bf16_t;
typedef float f32x4 __attribute__((ext_vector_type(4)));
typedef float f32x2 __attribute__((ext_vector_type(2)));
typedef float f32x16 __attribute__((ext_vector_type(16)));
typedef short bf16x8 __attribute__((ext_vector_type(8)));
typedef short s16x4 __attribute__((ext_vector_type(4)));
typedef unsigned u32x4 __attribute__((ext_vector_type(4)));
typedef unsigned u32x2 __attribute__((ext_vector_type(2)));
typedef __bf16 bf16x2_t __attribute__((ext_vector_type(2)));

constexpr int NB = 16, LSEQ = 2048, NC = 256, DM = 1024, NLAT = NB * LSEQ, NCTX = NB * NC, NTOK = NLAT + NCTX;
constexpr int PW = 2304;
constexpr int C_CQ = 0, C_CKV = 256, C_KR = 384, C_LX = 512, C_LG = 1024, C_SQ = 1536, C_SK = 2048, C_SV = 2176;
constexpr float EPS = 1e-6f, LOG2E = 1.4426950408889634f, LOG2_THETA = 13.287712379549449f;
constexpr int NTHR = 512, NWAVE = 8;
constexpr int LDS_BYTES = 147456;

constexpr size_t MiB = 1u << 20;
constexpr size_t WS_MOD = 131072;
constexpr size_t WS_W = 1 * MiB;
constexpr size_t W_IN = 0, W_S4 = W_IN + (size_t)2304 * 1024 * 2,
                 W_OUT = W_S4 + (size_t)4096 * 256 * 2, W_FF1 = W_OUT + (size_t)1024 * 1536 * 2, W_FF2 = W_FF1 + (size_t)4096 * 1024 * 2, W_END = W_FF2 + (size_t)1024 * 4096 * 2;
static_assert(W_END <= 26 * MiB && WS_MOD + 2 * 17 * 6144 * 4 <= WS_W, "weights");
constexpr size_t WS_XCRES = 27 * MiB;
constexpr size_t WS_R1 = 43 * MiB;
constexpr size_t WS_HN = WS_R1, WS_ACT = WS_R1;
constexpr size_t WS_KVR = 115 * MiB;
constexpr size_t WS_ON = WS_R1;
constexpr size_t WS_P = 205 * MiB;
constexpr size_t WS_AU = WS_P;
constexpr size_t WS_QR = 367 * MiB;
constexpr size_t WS_SQ = 421 * MiB;
constexpr size_t WS_LG = 457 * MiB;
constexpr size_t WS_SV = 493 * MiB;
constexpr size_t WS_KR = 502 * MiB;
constexpr size_t WS_H = 115 * MiB;
constexpr size_t WS_Y1 = 205 * MiB;
constexpr size_t WS_Y2 = 403 * MiB;
constexpr size_t WS_END = 512 * MiB;
static_assert(WS_H + (size_t)NTOK * 4096 * 2 <= WS_LG, "H overlay");

DI int tid_from(int WB) { int t; asm volatile("v_mbcnt_lo_u32_b32 %0, -1, 0\n\tv_mbcnt_hi_u32_b32 %0, -1, %0\n\tv_add_u32_e32 %0, %1, %0" : "=&v"(t) : "s"(WB)); return t; }
#define my_tid() tid_from(WB)
DI float bf2f(bf16_t v) { return __uint_as_float((unsigned)v << 16); }
DI float bflo(unsigned w) { return __uint_as_float(w << 16); }
DI float bfhi(unsigned w) { return __uint_as_float(w & 0xffff0000u); }
DI unsigned cvtpk(float lo, float hi) { f32x2 v = {lo, hi}; bf16x2_t b = __builtin_convertvector(v, bf16x2_t); return __builtin_bit_cast(unsigned, b); }
DI float shx(float v, int o, int lane) { return __int_as_float(__builtin_amdgcn_ds_bpermute((lane ^ o) << 2, __float_as_int(v))); }
#define SHX(v, o) shx((v), (o), lane)
DI float wave_sum_(float v, int lane) {
#pragma unroll
    for (int o = 1; o < 64; o <<= 1) v += SHX(v, o);
    return v;
}
#define wave_sum(v) wave_sum_((v), lane)
DI float sigmoidf_(float x) { return 1.f / (1.f + __expf(-x)); }

DI void phase_mod(const float* c, const float* cctx, const float* w_mod, const float* b_mod, float* MOD, LAS unsigned char* L, const int WB) {
    LAS float* act = (LAS float*)L;
    LAS float* red = (LAS float*)(L + 17 * 1024 * 4);
    const int tid = my_tid(), lane = tid & 63, wave = WB >> 6;
    for (int i = tid; i < 17 * 1024; i += NTHR) { const int r = i >> 10, k = i & 1023; const float v = r < 16 ? c[r * 1024 + k] : cctx[k]; act[i] = v / (1.f + __expf(-v)); }
    __syncthreads();
    for (int item = blockIdx.x; item < 2 * 96; item += gridDim.x) {
        const int l = item / 96, cgp = item % 96, col = cgp * 64 + lane;
        const float* w = w_mod + (size_t)l * 1024 * 6144 + col;
        float acc[17];
#pragma unroll
        for (int r = 0; r < 17; ++r) acc[r] = 0.f;
#pragma unroll 4
        for (int k = wave * 128; k < wave * 128 + 128; ++k) { const float wv = w[(size_t)k * 6144];
#pragma unroll
            for (int r = 0; r < 17; ++r) acc[r] += act[r * 1024 + k] * wv; }
#pragma unroll
        for (int r = 0; r < 17; ++r) red[(wave * 17 + r) * 64 + lane] = acc[r];
        __syncthreads();
        for (int i = tid; i < 17 * 64; i += NTHR) { const int r = i >> 6, cl = i & 63; float s = b_mod[l * 6144 + cgp * 64 + cl];
#pragma unroll
            for (int w8 = 0; w8 < 8; ++w8) s += red[(w8 * 17 + r) * 64 + cl];
            MOD[((size_t)l * 17 + r) * 6144 + cgp * 64 + cl] = s; }
        __syncthreads();
    }
}

DI void transpose_item(const float* W, int K, int N, bf16_t* WT, int k0, int n0, int dst_row0, LAS float* scr, int lane, int ldk = 0) {
    if (ldk == 0) ldk = K;
#pragma unroll 8
    for (int i = 0; i < 32; ++i) { const int kk = 2 * i + (lane >> 5); scr[kk * 33 + (lane & 31)] = W[(size_t)(k0 + kk) * N + n0 + (lane & 31)]; }
    asm volatile("s_waitcnt lgkmcnt(0)" ::: "memory");
    const int c = lane & 7;
#pragma unroll
    for (int j = 0; j < 4; ++j) { const int n = (lane >> 3) + 8 * j; const LAS float* s = scr + (8 * c) * 33 + n;
        u32x4 o; o.x = cvtpk(s[0 * 33], s[1 * 33]); o.y = cvtpk(s[2 * 33], s[3 * 33]); o.z = cvtpk(s[4 * 33], s[5 * 33]); o.w = cvtpk(s[6 * 33], s[7 * 33]);
        *(u32x4*)(WT + (size_t)(dst_row0 + n) * ldk + k0 + 8 * c) = o; }
    asm volatile("s_waitcnt lgkmcnt(0)" ::: "memory");
}
struct LayerW { const float *w_in, *w_uq, *w_ukv, *gate_w, *w_out, *w_ff1, *w_ff2; };
DI void phase_convert(const LayerW& lw, unsigned char* wsw, LAS unsigned char* L, const int WB, const int part = 0) {
    const int tid = my_tid(), lane = tid & 63, wave = WB >> 6;
    LAS float* scr = (LAS float*)(L + wave * 16384);
    const int gw = blockIdx.x * NWAVE + wave, NGW = gridDim.x * NWAVE;
    bf16_t* win_t = (bf16_t*)(wsw + W_IN); bf16_t* ws4 = (bf16_t*)(wsw + W_S4);
    bf16_t* wout_t = (bf16_t*)(wsw + W_OUT); bf16_t* wff1_t = (bf16_t*)(wsw + W_FF1); bf16_t* wff2_t = (bf16_t*)(wsw + W_FF2);
    constexpr int I_IN = 16 * 69, I_UQ = 4 * 24, I_UKV = 2 * 32, I_OUT = 24 * 32, I_F1 = 16 * 128, I_F2 = 64 * 32;
    constexpr int NITEMS = I_IN + I_UQ + I_UKV + I_OUT + I_F1 + I_F2;
    const int it_lo = part == 2 ? NITEMS - I_F2 : (part == 4 ? NITEMS - I_F2 - I_F1 : 0), it_hi = part == 1 ? NITEMS - I_F2 : (part == 3 ? NITEMS - I_F2 - I_F1 : NITEMS);
#pragma unroll 1
    for (int it = it_lo + gw; it < it_hi; it += NGW) {
        int r = it;
        if (r < I_IN) { const int kb = r / 69, nb = r % 69; transpose_item(lw.w_in, 1024, 2208, win_t, 64 * kb, 32 * nb, 32 * nb + (nb >= 13 ? 96 : 0), scr, lane); continue; } r -= I_IN;
        if (r < I_UQ) { const int kb = r / 24, nb = r % 24; transpose_item(lw.w_uq, 256, 768, ws4, 64 * kb, 32 * nb, 32 * nb, scr, lane); continue; } r -= I_UQ;
        if (r < I_UKV) { const int kb = r / 32, nb = r % 32; const int hh = nb >> 2, jb = nb & 3; const int dr = hh * 160 + (jb < 2 ? jb * 32 : 96 + (jb - 2) * 32);
            transpose_item(lw.w_ukv, 128, 1024, ws4, 64 * kb, 32 * nb, 768 + dr, scr, lane, 256); continue; } r -= I_UKV;
        if (r < I_OUT) { const int kb = r / 32, nb = r % 32; transpose_item(lw.w_out, 1536, 1024, wout_t, 64 * kb, 32 * nb, 32 * nb, scr, lane); continue; } r -= I_OUT;
        if (r < I_F1) { const int kb = r / 128, nb = r % 128; transpose_item(lw.w_ff1, 1024, 4096, wff1_t, 64 * kb, 32 * nb, 32 * nb, scr, lane); continue; } r -= I_F1;
        { const int kb = r / 32, nb = r % 32; transpose_item(lw.w_ff2, 4096, 1024, wff2_t, 64 * kb, 32 * nb, 32 * nb, scr, lane); }
    }
    if (part == 2 || part == 4) return;
    const int gt = blockIdx.x * NTHR + tid; constexpr int NGT = 256 * NTHR;
#pragma unroll 1
    for (int i = gt; i < 96 * 1024 / 2; i += NGT) ((unsigned*)(win_t + (size_t)416 * 1024))[i] = 0u;
#pragma unroll 1
    for (int i = gt; i < 1280 * 128; i += NGT) { const int row = i >> 7, k2 = i & 127; const int rr = row % 160; const bool slot = rr >= 64 && rr < 96;
        unsigned* rp = (unsigned*)(ws4 + (size_t)(768 + row) * 256); if (k2 >= 64 || slot) rp[k2] = 0u; }
#pragma unroll 1
    for (int i = gt; i < 4 * 512 * 256; i += NGT) { const int k = i & 255, p = (i >> 8) & 511, j = i >> 17;
        const int pn = p >> 8, z = (p >> 7) & 1, wc = (p >> 5) & 3, g = (p >> 4) & 1, fq = (p >> 2) & 3, ii = p & 3; const int cl = 64 * pn + 16 * wc + 4 * fq + ii;
        float v = 0.f; if (k < 128 && (k >> 6) == (cl >> 6)) { const int blk = 2 * j + (k >> 6); v = lw.gate_w[((((size_t)z * 2 + g) * 8 + blk) * 64 + (k & 63)) * 64 + (cl & 63)]; }
        ws4[(size_t)(2048 + 512 * j + p) * 256 + k] = (bf16_t)(cvtpk(v, 0.f) & 0xffffu); }
}

DI void norm_mod_row(const float* xrow, bf16_t* orow, const float* g, const float* shift, const float* scale, int lane) {
    f32x4 v[4]; float ss = 0.f;
#pragma unroll
    for (int j = 0; j < 4; ++j) { v[j] = *(const f32x4*)(xrow + 4 * lane + 256 * j); ss += (v[j].x * v[j].x + v[j].y * v[j].y) + (v[j].z * v[j].z + v[j].w * v[j].w); }
    const float rstd = rsqrtf(wave_sum(ss) * (1.f / 1024.f) + EPS);
#pragma unroll
    for (int j = 0; j < 4; ++j) { const int col = 4 * lane + 256 * j; const f32x4 gv = *(const f32x4*)(g + col), sh = *(const f32x4*)(shift + col), sc = *(const f32x4*)(scale + col);
        const f32x4 y = v[j] * rstd * gv * (sc + 1.f) + sh; u32x2 o; o.x = cvtpk(y.x, y.y); o.y = cvtpk(y.z, y.w); *(u32x2*)(orow + col) = o; }
}
DI void phase_norm(const float* xlat, const float* xctx, const bf16_t* Y, float* olat, float* octx, bf16_t* HN, const float* g, const float* modl, int chunk, int nrows, const int WB) {
    const int lane = my_tid() & 63, wave = WB >> 6;
    const int gw = blockIdx.x * NWAVE + wave, NGW = gridDim.x * NWAVE;
    for (int r = gw; r < nrows; r += 2 * NGW) {
        const int r2 = r + NGW; const bool has2 = r2 < nrows; const int rb = has2 ? r2 : r;
        const bool latA = r < NLAT, latB = rb < NLAT;
        const float* xa = latA ? xlat + (size_t)r * 1024 : xctx + (size_t)(r - NLAT) * 1024;
        const float* xb = latB ? xlat + (size_t)rb * 1024 : xctx + (size_t)(rb - NLAT) * 1024;
        f32x4 va[4], vb[4]; float sa = 0.f, sb = 0.f;
#pragma unroll
        for (int j = 0; j < 4; ++j) { va[j] = *(const f32x4*)(xa + 4 * lane + 256 * j); vb[j] = *(const f32x4*)(xb + 4 * lane + 256 * j); }
        if (Y) {
            float* oa = latA ? olat + (size_t)r * 1024 : octx + (size_t)(r - NLAT) * 1024;
            float* ob = latB ? olat + (size_t)rb * 1024 : octx + (size_t)(rb - NLAT) * 1024;
#pragma unroll
            for (int j = 0; j < 4; ++j) { const u32x2 ya = *(const u32x2*)(Y + (size_t)r * 1024 + 4 * lane + 256 * j), yb = *(const u32x2*)(Y + (size_t)rb * 1024 + 4 * lane + 256 * j);
                va[j].x += bflo(ya.x); va[j].y += bfhi(ya.x); va[j].z += bflo(ya.y); va[j].w += bfhi(ya.y);
                vb[j].x += bflo(yb.x); vb[j].y += bfhi(yb.x); vb[j].z += bflo(yb.y); vb[j].w += bfhi(yb.y);
                *(f32x4*)(oa + 4 * lane + 256 * j) = va[j]; if (has2) *(f32x4*)(ob + 4 * lane + 256 * j) = vb[j]; }
        }
#pragma unroll
        for (int j = 0; j < 4; ++j) { sa += (va[j].x * va[j].x + va[j].y * va[j].y) + (va[j].z * va[j].z + va[j].w * va[j].w); sb += (vb[j].x * vb[j].x + vb[j].y * vb[j].y) + (vb[j].z * vb[j].z + vb[j].w * vb[j].w); }
#pragma unroll
        for (int o = 1; o < 64; o <<= 1) { sa += SHX(sa, o); sb += SHX(sb, o); }
        const float ra = rsqrtf(sa * (1.f / 1024.f) + EPS), rbs = rsqrtf(sb * (1.f / 1024.f) + EPS);
        const float* ma = modl + (size_t)(latA ? (r >> 11) : 16) * 6144 + chunk * 1024; const float* mb = modl + (size_t)(latB ? (rb >> 11) : 16) * 6144 + chunk * 1024;
#pragma unroll
        for (int j = 0; j < 4; ++j) { const int col = 4 * lane + 256 * j; const f32x4 gv = *(const f32x4*)(g + col);
            { const f32x4 sh = *(const f32x4*)(ma + col), sc = *(const f32x4*)(ma + 1024 + col); const f32x4 y = va[j] * ra * gv * (sc + 1.f) + sh; u32x2 o; o.x = cvtpk(y.x, y.y); o.y = cvtpk(y.z, y.w); *(u32x2*)(HN + (size_t)r * 1024 + col) = o; }
            if (has2) { const f32x4 sh = *(const f32x4*)(mb + col), sc = *(const f32x4*)(mb + 1024 + col); const f32x4 y = vb[j] * rbs * gv * (sc + 1.f) + sh; u32x2 o; o.x = cvtpk(y.x, y.y); o.y = cvtpk(y.z, y.w); *(u32x2*)(HN + (size_t)r2 * 1024 + col) = o; } }
    }
}
DI void load8(const bf16_t* p, float (&v)[8]) { const u32x4 w = *(const u32x4*)p; v[0] = bflo(w.x); v[1] = bfhi(w.x); v[2] = bflo(w.y); v[3] = bfhi(w.y); v[4] = bflo(w.z); v[5] = bfhi(w.z); v[6] = bflo(w.w); v[7] = bfhi(w.w); }
DI void store8(bf16_t* p, const float (&v)[8]) { u32x4 w; w.x = cvtpk(v[0], v[1]); w.y = cvtpk(v[2], v[3]); w.z = cvtpk(v[4], v[5]); w.w = cvtpk(v[6], v[7]); *(u32x4*)p = w; }
DI void head64_norm_rope(float (&v)[8], const float* g, int lane, bool rope, int prow, int pcol, float outscale) {
    const int li = lane & 7;
    float ss = 0.f;
#pragma unroll
    for (int e = 0; e < 8; ++e) ss += v[e] * v[e];
    ss += SHX(ss, 1); ss += SHX(ss, 2); ss += SHX(ss, 4);
    const float rstd = rsqrtf(ss * (1.f / 64.f) + EPS);
    const int axis = li >> 2, half = (li >> 1) & 1; const float pos = (float)(axis ? pcol : prow);
#pragma unroll
    for (int e = 0; e < 8; ++e) v[e] = v[e] * rstd * g[8 * li + e];
#pragma unroll
    for (int e = 0; e < 8; ++e) { const float p = SHX(v[e], 2);
        if (rope) { const int i = 8 * (li & 1) + e; const float ang = pos * __builtin_amdgcn_exp2f(-(float)i * (LOG2_THETA / 16.f));
            const float cs = __cosf(ang), sn = __sinf(ang); const float rot = half ? p : -p; v[e] = v[e] * cs + rot * sn; } }
#pragma unroll
    for (int e = 0; e < 8; ++e) v[e] *= outscale;
}
struct PrepW { const float *q_a_g, *kv_a_g, *conv_w, *conv_b, *swa_q_g, *swa_k_g; };
DI void phase_prep(const bf16_t* __restrict__ P, const PrepW& w, bf16_t* __restrict__ ACT, bf16_t* __restrict__ KR, bf16_t* __restrict__ SV, bool last, const int WB) {
    const int lane = my_tid() & 63, wave = WB >> 6;
    const int gw = blockIdx.x * NWAVE + wave, NGW = gridDim.x * NWAVE;
    const f32x4 gq = *(const f32x4*)(w.q_a_g + 4 * lane);
    const float gkv0 = w.kv_a_g[2 * lane], gkv1 = w.kv_a_g[2 * lane + 1];
    float cw[4][8], cb[8], gk[8], frq[8];
    const int li = lane & 7, l16 = lane & 15; const int axis = li >> 2; const bool half = (li >> 1) & 1;
#pragma unroll
    for (int e = 0; e < 8; ++e) { cb[e] = w.conv_b[8 * lane + e]; gk[e] = w.swa_k_g[8 * li + e]; frq[e] = __builtin_amdgcn_exp2f(-(float)(8 * (li & 1) + e) * (LOG2_THETA / 16.f));
#pragma unroll
        for (int t = 0; t < 4; ++t) cw[t][e] = w.conv_w[t * 512 + 8 * lane + e]; }
    for (int r0 = gw; r0 < NTOK; r0 += 2 * NGW) {
        int rr[2]; bool lat[2]; int pos[2];
        u32x2 cqv[2]; unsigned ckvv[2], krv[2]; u32x4 lxv[2][4], skv[2], svv[2]; float msk[2][4];
#pragma unroll
        for (int k = 0; k < 2; ++k) {
            int r = r0 + k * NGW; if (r >= NTOK) r = r0;
            rr[k] = r; lat[k] = r < NLAT; pos[k] = lat[k] ? (r & (LSEQ - 1)) : ((r - NLAT) & (NC - 1)); const int slen = lat[k] ? LSEQ : NC;
            const bf16_t* pr = P + (size_t)r * PW;
            cqv[k] = *(const u32x2*)(pr + C_CQ + 4 * lane); ckvv[k] = *(const unsigned*)(pr + C_CKV + 2 * lane); krv[k] = *(const unsigned*)(pr + C_KR + 2 * l16);
#pragma unroll
            for (int t = 0; t < 4; ++t) { const int pp = pos[k] + t - 2; const bool ok = pp >= 0 && pp < slen; msk[k][t] = ok ? 1.f : 0.f;
                lxv[k][t] = *(const u32x4*)(pr + (ptrdiff_t)(ok ? t - 2 : 0) * PW + C_LX + 8 * lane); }
            skv[k] = *(const u32x4*)(pr + C_SK + 8 * l16); svv[k] = *(const u32x4*)(pr + C_SV + 8 * l16);
        }
        float a[2][4], bq[2][2], sq_[2], sk_[2], kv[2][8], s8[2];
#pragma unroll
        for (int k = 0; k < 2; ++k) {
            a[k][0] = bflo(cqv[k].x); a[k][1] = bfhi(cqv[k].x); a[k][2] = bflo(cqv[k].y); a[k][3] = bfhi(cqv[k].y);
            sq_[k] = (a[k][0] * a[k][0] + a[k][1] * a[k][1]) + (a[k][2] * a[k][2] + a[k][3] * a[k][3]);
            bq[k][0] = bflo(ckvv[k]); bq[k][1] = bfhi(ckvv[k]); sk_[k] = bq[k][0] * bq[k][0] + bq[k][1] * bq[k][1];
            kv[k][0] = bflo(skv[k].x); kv[k][1] = bfhi(skv[k].x); kv[k][2] = bflo(skv[k].y); kv[k][3] = bfhi(skv[k].y); kv[k][4] = bflo(skv[k].z); kv[k][5] = bfhi(skv[k].z); kv[k][6] = bflo(skv[k].w); kv[k][7] = bfhi(skv[k].w);
            s8[k] = 0.f;
#pragma unroll
            for (int e = 0; e < 8; ++e) s8[k] += kv[k][e] * kv[k][e];
        }
#pragma unroll
        for (int o = 1; o < 64; o <<= 1) { sq_[0] += SHX(sq_[0], o); sq_[1] += SHX(sq_[1], o); sk_[0] += SHX(sk_[0], o); sk_[1] += SHX(sk_[1], o);
            if (o < 8) { s8[0] += SHX(s8[0], o); s8[1] += SHX(s8[1], o); } }
#pragma unroll
        for (int k = 0; k < 2; ++k) {
            const int r = rr[k]; bf16_t* arow = ACT + (size_t)r * 1024;
            {
                const float rstd = rsqrtf(sq_[k] * (1.f / 256.f) + EPS);
                u32x2 o; o.x = cvtpk(a[k][0] * rstd * gq.x, a[k][1] * rstd * gq.y); o.y = cvtpk(a[k][2] * rstd * gq.z, a[k][3] * rstd * gq.w);
                if (last && !lat[k]) { o.x = 0u; o.y = 0u; }
                *(u32x2*)(arow + 4 * lane) = o; }
            {
                const float rstd = rsqrtf(sk_[k] * (1.f / 128.f) + EPS);
                *(unsigned*)(arow + 256 + 2 * lane) = cvtpk(bq[k][0] * rstd * gkv0, bq[k][1] * rstd * gkv1); }
            if (lane < 16) *(unsigned*)(KR + (size_t)r * 32 + 2 * lane) = krv[k];
            {
                float acc[8];
#pragma unroll
                for (int e = 0; e < 8; ++e) acc[e] = cb[e];
#pragma unroll
                for (int t = 0; t < 4; ++t) { const u32x4 xw = lxv[k][t]; const float mm = msk[k][t];
                    const float xv[8] = {bflo(xw.x), bfhi(xw.x), bflo(xw.y), bfhi(xw.y), bflo(xw.z), bfhi(xw.z), bflo(xw.w), bfhi(xw.w)};
#pragma unroll
                    for (int e = 0; e < 8; ++e) acc[e] += (xv[e] * mm) * cw[t][e]; }
                store8(arow + 512 + 8 * lane, acc); }
            {
                const float rstd = rsqrtf(s8[k] * (1.f / 64.f) + EPS); const float pa = (float)(axis ? (pos[k] & 63) : (pos[k] >> 6));
                float v[8];
#pragma unroll
                for (int e = 0; e < 8; ++e) v[e] = kv[k][e] * rstd * gk[e];
#pragma unroll
                for (int e = 0; e < 8; ++e) { const float p = SHX(v[e], 2);
                    if (lat[k]) { const float ang = pa * frq[e]; const float cs = __cosf(ang), sn = __sinf(ang); const float rot = half ? p : -p; v[e] = v[e] * cs + rot * sn; } }
                if (lane < 16) { store8(arow + 384 + 8 * lane, v); *(u32x4*)(SV + (size_t)r * 128 + 8 * lane) = svv[k]; } }
        }
    }
}

struct FinW { const float *mla_q_g, *mla_k_g; };
DI void load4(const bf16_t* p, float (&v)[4]) { const u32x2 w = *(const u32x2*)p; v[0] = bflo(w.x); v[1] = bfhi(w.x); v[2] = bflo(w.y); v[3] = bfhi(w.y); }
DI void store4(bf16_t* p, const float (&v)[4]) { u32x2 w; w.x = cvtpk(v[0], v[1]); w.y = cvtpk(v[2], v[3]); *(u32x2*)p = w; }
DI void head96_finish(float (&a)[8], float (&b)[4], const float (&g8)[8], const float (&g4)[4], const float (&cs)[4], const float (&sn)[4], bool half, float osc, int lane) {
    float ss = 0.f;
#pragma unroll
    for (int e = 0; e < 8; ++e) ss += a[e] * a[e];
#pragma unroll
    for (int e = 0; e < 4; ++e) ss += b[e] * b[e];
    ss += SHX(ss, 1); ss += SHX(ss, 2); ss += SHX(ss, 4);
    const float rstd = rsqrtf(ss * (1.f / 96.f) + EPS) ;
#pragma unroll
    for (int e = 0; e < 8; ++e) a[e] = a[e] * rstd * g8[e] * osc;
#pragma unroll
    for (int e = 0; e < 4; ++e) b[e] = b[e] * rstd * g4[e];
#pragma unroll
    for (int e = 0; e < 4; ++e) { const float p = SHX(b[e], 2); const float rot = half ? p : -p; b[e] = (b[e] * cs[e] + rot * sn[e]) * osc; }
}
DI void phase_finish(bf16_t* QR, bf16_t* KVR, const bf16_t* KR, const FinW& w, int nq_rows, const int WB) {
    const int lane = my_tid() & 63, wave = WB >> 6;
    const int gw = blockIdx.x * NWAVE + wave, NGW = gridDim.x * NWAVE;
    const int hh = lane >> 3, li = lane & 7;
    const int axis = li >> 2; const bool half = (li >> 1) & 1;
    float fr[4], gq8[8], gq4[4], gk8[8], gk4[4];
#pragma unroll
    for (int e = 0; e < 4; ++e) { fr[e] = __builtin_amdgcn_exp2f(-(float)(4 * (li & 1) + e) * (LOG2_THETA / 8.f)); gq4[e] = w.mla_q_g[64 + 4 * li + e]; gk4[e] = w.mla_k_g[64 + 4 * li + e]; }
#pragma unroll
    for (int e = 0; e < 8; ++e) { gq8[e] = w.mla_q_g[8 * li + e]; gk8[e] = w.mla_k_g[8 * li + e]; }
    if (nq_rows > 0) {
        for (int r = gw; r < nq_rows; r += NGW) {
            const bool lat = r < NLAT; const int pos = r & (LSEQ - 1); const float pa = (float)(axis ? (pos & 63) : (pos >> 6));
            float cs[4], sn[4];
#pragma unroll
            for (int e = 0; e < 4; ++e) { cs[e] = lat ? __cosf(pa * fr[e]) : 1.f; sn[e] = lat ? __sinf(pa * fr[e]) : 0.f; }
            bf16_t* qp = QR + (size_t)r * 768 + hh * 96; float a[8], b[4]; load8(qp + 8 * li, a); load4(qp + 64 + 4 * li, b);
            head96_finish(a, b, gq8, gq4, cs, sn, half, 0.10206207261596575f * LOG2E, lane);
            store8(qp + 8 * li, a); store4(qp + 64 + 4 * li, b);
        }
    }
    for (int r0 = gw; r0 < NTOK; r0 += 4 * NGW) {
        u32x4 av[4]; u32x2 bv[4]; int rr[4];
#pragma unroll
        for (int k = 0; k < 4; ++k) { int r = r0 + k * NGW; if (r >= NTOK) r = r0; rr[k] = r;
            av[k] = *(const u32x4*)(KVR + (size_t)r * 1280 + hh * 160 + 8 * li); bv[k] = *(const u32x2*)(KR + (size_t)r * 32 + 4 * li); }
        float a[4][8], b[4][4], ss[4];
#pragma unroll
        for (int k = 0; k < 4; ++k) { const u32x4 w4 = av[k]; const u32x2 w2 = bv[k];
            a[k][0] = bflo(w4.x); a[k][1] = bfhi(w4.x); a[k][2] = bflo(w4.y); a[k][3] = bfhi(w4.y); a[k][4] = bflo(w4.z); a[k][5] = bfhi(w4.z); a[k][6] = bflo(w4.w); a[k][7] = bfhi(w4.w);
            b[k][0] = bflo(w2.x); b[k][1] = bfhi(w2.x); b[k][2] = bflo(w2.y); b[k][3] = bfhi(w2.y);
            ss[k] = 0.f;
#pragma unroll
            for (int e = 0; e < 8; ++e) ss[k] += a[k][e] * a[k][e];
#pragma unroll
            for (int e = 0; e < 4; ++e) ss[k] += b[k][e] * b[k][e]; }
#pragma unroll
        for (int o = 1; o < 8; o <<= 1) {
#pragma unroll
            for (int k = 0; k < 4; ++k) ss[k] += SHX(ss[k], o); }
#pragma unroll
        for (int k = 0; k < 4; ++k) {
            const int r = rr[k]; const bool lat = r < NLAT; const int pos = r & (LSEQ - 1); const float pa = (float)(axis ? (pos & 63) : (pos >> 6));
            const float rstd = rsqrtf(ss[k] * (1.f / 96.f) + EPS);
#pragma unroll
            for (int e = 0; e < 8; ++e) a[k][e] = a[k][e] * rstd * gk8[e];
#pragma unroll
            for (int e = 0; e < 4; ++e) b[k][e] = b[k][e] * rstd * gk4[e];
#pragma unroll
            for (int e = 0; e < 4; ++e) { const float p = SHX(b[k][e], 2);
                if (lat) { const float ang = pa * fr[e]; const float cs = __cosf(ang), sn = __sinf(ang); const float rot = half ? p : -p; b[k][e] = b[k][e] * cs + rot * sn; } }
            bf16_t* kp = KVR + (size_t)r * 1280 + hh * 160;
            store8(kp + 8 * li, a[k]); store4(kp + 64 + 4 * li, b[k]);
        }
    }
}

DI int scan_row(int b, int dir, int s) {
    if (s < NC) return NLAT + b * NC + (dir ? (NC - 1 - s) : s);
    const int l = s - NC; return b * LSEQ + (dir ? (LSEQ - 1 - l) : l);
}
DI void phase_scan(unsigned* AU, LAS unsigned char* L, const int WB) {
    LAS float* sA = (LAS float*)L; LAS float* sH = (LAS float*)(L + 2048);
    const int tid = my_tid(), ch = tid & 15, seg = tid >> 4;
    for (int u = (int)((blockIdx.x & 7) * (gridDim.x >> 3) + (blockIdx.x >> 3)); u < NB * 32; u += gridDim.x) {
        const int cgp = u & 31, b = u >> 5;
#pragma unroll 1
        for (int dir = 0; dir < 2; ++dir) {
            unsigned* base = AU + (size_t)dir * NTOK * 512 + cgp * 16 + ch;
            float* sum = (float*)(AU + cgp * 16 + ch);
            unsigned wv[72];
            const int s0 = seg * 72;
            const int dstride = dir ? -512 : 512;
            const int jump = (scan_row(b, dir, 256) - scan_row(b, dir, 255)) * 512;
            const unsigned idx0 = (unsigned)scan_row(b, dir, s0) * 512u;
            unsigned idx = idx0;
#pragma unroll
            for (int s = 0; s < 72; ++s) { wv[s] = base[idx]; idx += (unsigned)((s0 + s == 255) ? jump : dstride); asm volatile("" : "+v"(idx)); }
            float A = 1.f, H = 0.f;
#pragma unroll
            for (int s = 0; s < 72; ++s) { const float a = __builtin_amdgcn_exp2f(bflo(wv[s])), uu = bfhi(wv[s]); H = a * H + uu; A *= a; }
            sA[seg * 16 + ch] = A; sH[seg * 16 + ch] = H;
            __syncthreads();
            float h = 0.f;
            for (int s2 = 0; s2 < seg; ++s2) h = sA[s2 * 16 + ch] * h + sH[s2 * 16 + ch];
            idx = idx0;
            if (dir == 0) {
#pragma unroll
                for (int s = 0; s < 72; ++s) { const float a = __builtin_amdgcn_exp2f(bflo(wv[s])), uu = bfhi(wv[s]); h = a * h + uu; sum[idx] = h; idx += (unsigned)((s0 + s == 255) ? jump : dstride); asm volatile("" : "+v"(idx)); }
            } else {
                float hf[72];
#pragma unroll
                for (int s = 0; s < 72; ++s) { hf[s] = sum[idx]; idx += (unsigned)((s0 + s == 255) ? jump : dstride); asm volatile("" : "+v"(idx)); }
                idx = idx0;
#pragma unroll
                for (int s = 0; s < 72; ++s) { const float a = __builtin_amdgcn_exp2f(bflo(wv[s])), uu = bfhi(wv[s]); h = a * h + uu; sum[idx] = hf[s] + h; idx += (unsigned)((s0 + s == 255) ? jump : dstride); asm volatile("" : "+v"(idx)); }
            }
            __syncthreads();
        }
    }
}

DI float gelu_tanh(float x) { const float z = 0.7978845608028654f * (x + 0.044715f * x * x * x); const float t = 1.f - 2.f * __builtin_amdgcn_rcpf(1.f + __expf(2.f * z)); return 0.5f * x * (1.f + t); }
DI void group_out(float (&v)[8], const float* g, bf16_t* dst, int lane) {
    float ss = 0.f;
#pragma unroll
    for (int e = 0; e < 8; ++e) ss += v[e] * v[e];
    const float rstd = rsqrtf(wave_sum(ss) * (1.f / 512.f) + EPS);
#pragma unroll
    for (int e = 0; e < 8; ++e) v[e] = v[e] * rstd * g[e];
    store8(dst, v);
}
DI void phase_groupnorm(const bf16_t* OA, const float* HS, const bf16_t* LG, const bf16_t* OC, const float* gg, bf16_t* ON, int nrows, const int WB) {
    const int lane = my_tid() & 63, wave = WB >> 6;
    const int gw = blockIdx.x * NWAVE + wave, NGW = gridDim.x * NWAVE;
    for (int r = gw; r < nrows; r += NGW) {
        float v[8];
        load8(OA + (size_t)r * 768 + (lane >> 3) * 96 + (lane & 7) * 8, v);
        group_out(v, gg + 8 * lane, ON + (size_t)r * 1536 + 8 * lane, lane);
        float lg[8]; load8(LG + (size_t)r * 512 + 8 * lane, lg);
        const f32x4 f0 = *(const f32x4*)(HS + (size_t)r * 512 + 8 * lane), f1 = *(const f32x4*)(HS + (size_t)r * 512 + 8 * lane + 4);
#pragma unroll
        for (int e = 0; e < 4; ++e) { v[e] = f0[e] * gelu_tanh(lg[e]); v[4 + e] = f1[e] * gelu_tanh(lg[4 + e]); }
        group_out(v, gg + 512 + 8 * lane, ON + (size_t)r * 1536 + 512 + 8 * lane, lane);
        load8(OC + (size_t)r * 512 + 8 * lane, v);
        group_out(v, gg + 1024 + 8 * lane, ON + (size_t)r * 1536 + 1024 + 8 * lane, lane);
    }
}
struct AttnU { const bf16_t *Q, *KA, *KB, *VA, *VB; bf16_t* O; int qs, ks, vs, os, na, nb, kb0, q0, W; float sink; int has_sink; const float* qg; int qrope; int two; float sink2; };
#define MFMA32(a, b, c) __builtin_amdgcn_mfma_f32_32x32x16_bf16((a), (b), (c), 0, 0, 0)
#define LDS_BAR() do { asm volatile("s_waitcnt lgkmcnt(0)" ::: "memory"); __builtin_amdgcn_s_barrier(); asm volatile("" ::: "memory"); } while (0)
typedef short v4i16_t __attribute__((ext_vector_type(4)));
DI float max3f(float a, float b, float c) { float r; asm("v_max3_f32 %0, %1, %2, %3" : "=v"(r) : "v"(a), "v"(b), "v"(c)); return r; }
DI float max2f(float a, float b) { float r; asm("v_max_f32_e32 %0, %1, %2" : "=v"(r) : "v"(a), "v"(b)); return r; }
DI s16x4 vtr(const LAS unsigned char* p) { return __builtin_bit_cast(s16x4, __builtin_amdgcn_ds_read_tr16_b64_v4i16((LAS v4i16_t*)p)); }
template <int DQ> DI void attn_unit(const AttnU& a, LAS unsigned char* L, int tid, const int WB) {
    constexpr int KSTR = DQ * 2 + 16, VSTR = 144, KBUF = 64 * KSTR, VBUF = 64 * VSTR, NS = DQ / 16, CPR = DQ / 8, NCH = 64 * CPR;
    const int lane = tid & 63, wave = WB >> 6, r = lane & 31, h = lane >> 5;
    const int wrow = a.two ? (wave & 3) * 32 : wave * 32, hoff = a.two ? (wave >> 2) * 64 : 0;
    bf16x8 qf[NS];
    { const bf16_t* qrow = a.Q + (size_t)(wrow + r) * a.qs + hoff + 8 * h;
#pragma unroll
      for (int s = 0; s < NS; ++s) qf[s] = *(const bf16x8*)(qrow + 16 * s); }
    if constexpr (DQ == 96) {
        if (a.qg) {
            float qv[NS][8]; float ss = 0.f;
#pragma unroll
            for (int s = 0; s < NS; ++s) { const u32x4 w = __builtin_bit_cast(u32x4, qf[s]);
                qv[s][0] = bflo(w.x); qv[s][1] = bfhi(w.x); qv[s][2] = bflo(w.y); qv[s][3] = bfhi(w.y); qv[s][4] = bflo(w.z); qv[s][5] = bfhi(w.z); qv[s][6] = bflo(w.w); qv[s][7] = bfhi(w.w);
#pragma unroll
                for (int j = 0; j < 8; ++j) ss += qv[s][j] * qv[s][j]; }
            ss += SHX(ss, 32);
            const float rs = rsqrtf(ss * (1.f / 96.f) + EPS);
#pragma unroll
            for (int s = 0; s < NS; ++s)
#pragma unroll
                for (int j = 0; j < 8; ++j) qv[s][j] *= rs * a.qg[16 * s + 8 * h + j];
            const int pos = a.q0 + wrow + r;
#pragma unroll
            for (int s = 4; s < 6; ++s) { const float pa = (float)(s == 4 ? (pos >> 6) : (pos & 63));
#pragma unroll
                for (int j = 0; j < 8; ++j) { const float p = SHX(qv[s][j], 32);
                    if (a.qrope) { const float ang = pa * __builtin_amdgcn_exp2f(-(float)j * (LOG2_THETA / 8.f)); const float cs = __cosf(ang), sn = __sinf(ang); const float rot = h ? p : -p; qv[s][j] = qv[s][j] * cs + rot * sn; } } }
            const float qsc = 0.10206207261596575f * LOG2E;
#pragma unroll
            for (int s = 0; s < NS; ++s) { u32x4 w; w.x = cvtpk(qv[s][0] * qsc, qv[s][1] * qsc); w.y = cvtpk(qv[s][2] * qsc, qv[s][3] * qsc); w.z = cvtpk(qv[s][4] * qsc, qv[s][5] * qsc); w.w = cvtpk(qv[s][6] * qsc, qv[s][7] * qsc);
                qf[s] = __builtin_bit_cast(bf16x8, w); }
        }
    }
    if constexpr (DQ == 64) {
        if (a.qg) {
            float qv[NS][8]; float ss = 0.f;
#pragma unroll
            for (int s = 0; s < NS; ++s) { const u32x4 w = __builtin_bit_cast(u32x4, qf[s]);
                qv[s][0] = bflo(w.x); qv[s][1] = bfhi(w.x); qv[s][2] = bflo(w.y); qv[s][3] = bfhi(w.y); qv[s][4] = bflo(w.z); qv[s][5] = bfhi(w.z); qv[s][6] = bflo(w.w); qv[s][7] = bfhi(w.w);
#pragma unroll
                for (int j = 0; j < 8; ++j) ss += qv[s][j] * qv[s][j]; }
            ss += SHX(ss, 32);
            const float rs = rsqrtf(ss * (1.f / 64.f) + EPS);
#pragma unroll
            for (int s = 0; s < NS; ++s)
#pragma unroll
                for (int j = 0; j < 8; ++j) qv[s][j] *= rs * a.qg[16 * s + 8 * h + j];
            if (a.qrope) {
                const int pos = a.q0 + wrow + r;
#pragma unroll
                for (int ax = 0; ax < 2; ++ax) { const float pa = (float)(ax == 0 ? (pos >> 6) : (pos & 63));
#pragma unroll
                    for (int j = 0; j < 8; ++j) { const float ang = pa * __builtin_amdgcn_exp2f(-(float)(8 * h + j) * (LOG2_THETA / 16.f)); const float cs = __cosf(ang), sn = __sinf(ang);
                        const float lo = qv[2 * ax][j], hi = qv[2 * ax + 1][j]; qv[2 * ax][j] = lo * cs - hi * sn; qv[2 * ax + 1][j] = hi * cs + lo * sn; } }
            }
            const float qsc = 0.125f * LOG2E;
#pragma unroll
            for (int s = 0; s < NS; ++s) { u32x4 w; w.x = cvtpk(qv[s][0] * qsc, qv[s][1] * qsc); w.y = cvtpk(qv[s][2] * qsc, qv[s][3] * qsc); w.z = cvtpk(qv[s][4] * qsc, qv[s][5] * qsc); w.w = cvtpk(qv[s][6] * qsc, qv[s][7] * qsc);
                qf[s] = __builtin_bit_cast(bf16x8, w); }
        }
    }
    f32x16 o0, o1;
#pragma unroll
    for (int i = 0; i < 16; ++i) { o0[i] = 0.f; o1[i] = 0.f; }
    float m = a.has_sink ? ((a.two && wave >= 4) ? a.sink2 : a.sink) : 0.f, l = (a.has_sink && h == 0) ? 1.f : 0.f;
    f32x16 negm;
#pragma unroll
    for (int i = 0; i < 16; ++i) negm[i] = -m;
    const int nt = (a.na + a.nb) >> 6;
    const int c0r = tid / CPR, c0c = tid % CPR, c1r = (tid + 512) / CPR, c1c = (tid + 512) % CPR, vkey = tid >> 3, vc = tid & 7;
    u32x4 kA0, kA1 = {0u, 0u, 0u, 0u}, vA, kB0, kB1 = {0u, 0u, 0u, 0u}, vB;
#define GLOAD(t, K0, K1, VV) do { const int k0_ = (t) * 64; const bf16_t* kp_; const bf16_t* vp_; \
        if (k0_ < a.na) { kp_ = a.KA + (size_t)k0_ * a.ks; vp_ = a.VA + (size_t)k0_ * a.vs; } else { kp_ = a.KB + (size_t)(k0_ - a.na) * a.ks; vp_ = a.VB + (size_t)(k0_ - a.na) * a.vs; } \
        K0 = *(const u32x4*)(kp_ + (size_t)c0r * a.ks + c0c * 8); \
        if (NCH > 512) { if (tid < NCH - 512) K1 = *(const u32x4*)(kp_ + (size_t)c1r * a.ks + c1c * 8); } \
        VV = *(const u32x4*)(vp_ + (size_t)vkey * a.vs + vc * 8); } while (0)
#define LSTORE(buf, K0, K1, VV) do { *(LAS u32x4*)(L + (buf) * KBUF + c0r * KSTR + c0c * 16) = K0; \
        if (NCH > 512) { if (tid < NCH - 512) *(LAS u32x4*)(L + (buf) * KBUF + c1r * KSTR + c1c * 16) = K1; } \
        *(LAS u32x4*)(L + 4 * KBUF + (buf) * VBUF + vkey * VSTR + vc * 16) = VV; } while (0)
    const int iq = a.q0 + wrow + r, iq0 = a.q0 + wrow;
    const int i16 = lane & 15, tq = i16 >> 2, tp = i16 & 3, tblk = (lane >> 4) & 1;
    const int vtoff = (4 * h + tq) * VSTR + 8 * (4 * tblk + tp);
    auto compute = [&](int t, int buf) {
        const int k0 = t * 64; const bool masked = (k0 >= a.na) && (a.W < LSEQ); const int kpos0 = a.kb0 + (k0 - a.na);
        if (masked && (kpos0 > iq0 + 31 + a.W || kpos0 + 63 < iq0 - a.W)) return;
        LAS unsigned char* Kb = L + buf * KBUF; LAS unsigned char* Vb = L + 4 * KBUF + buf * VBUF;
        f32x16 s0 = negm, s1 = negm;
#pragma unroll
        for (int s_ = 0; s_ < NS; ++s_) {
            const bf16x8 kf0 = *(const LAS bf16x8*)(Kb + r * KSTR + (16 * s_ + 8 * h) * 2);
            const bf16x8 kf1 = *(const LAS bf16x8*)(Kb + (32 + r) * KSTR + (16 * s_ + 8 * h) * 2);
            s0 = MFMA32(kf0, qf[s_], s0); s1 = MFMA32(kf1, qf[s_], s1); }
        if (masked && !(kpos0 >= iq0 + 31 - a.W && kpos0 + 63 <= iq0 + a.W)) {
#pragma unroll
            for (int i = 0; i < 16; ++i) { const int j = kpos0 + (i & 3) + 8 * (i >> 2) + 4 * h; const int dlt = iq - j;
                if (dlt > a.W || dlt < -a.W) s0[i] = -1e30f; if (dlt - 32 > a.W || dlt - 32 < -a.W) s1[i] = -1e30f; }
        }
        float ma = max3f(s0[0], s0[1], s0[2]), mb = max3f(s0[8], s0[9], s0[10]), mc = max3f(s1[0], s1[1], s1[2]), md = max3f(s1[8], s1[9], s1[10]);
        ma = max3f(ma, s0[3], s0[4]); mb = max3f(mb, s0[11], s0[12]); mc = max3f(mc, s1[3], s1[4]); md = max3f(md, s1[11], s1[12]);
        ma = max3f(ma, s0[5], s0[6]); mb = max3f(mb, s0[13], s0[14]); mc = max3f(mc, s1[5], s1[6]); md = max3f(md, s1[13], s1[14]);
        ma = max2f(ma, s0[7]); mb = max2f(mb, s0[15]); mc = max2f(mc, s1[7]); md = max2f(md, s1[15]);
        float mx = max2f(max3f(ma, mb, mc), md);
        const bool first = (!a.has_sink) && (t == 0);
        if (first || __builtin_amdgcn_ballot_w64(mx > 8.f) != 0ull) {
            mx = max2f(mx, SHX(mx, 32));
            const float d = first ? mx : max2f(mx, 0.f); const float alpha = first ? 0.f : __builtin_amdgcn_exp2f(-d); m += d; l *= alpha;
#pragma unroll
            for (int i = 0; i < 16; ++i) { o0[i] *= alpha; o1[i] *= alpha; s0[i] -= d; s1[i] -= d; negm[i] = -m; }
        }
        f32x2 lsv = {0.f, 0.f};
#pragma unroll
        for (int i = 0; i < 16; ++i) { s0[i] = __builtin_amdgcn_exp2f(s0[i]); s1[i] = __builtin_amdgcn_exp2f(s1[i]); }
#pragma unroll
        for (int i = 0; i < 16; i += 2) { lsv += (f32x2){s0[i], s0[i + 1]}; lsv += (f32x2){s1[i], s1[i + 1]}; }
        l += lsv.x + lsv.y;
        u32x4 pw;
#pragma unroll
        for (int kh = 0; kh < 2; ++kh) {
#pragma unroll
            for (int s2 = 0; s2 < 2; ++s2) {
                if (kh == 0) { pw.x = cvtpk(s0[8 * s2], s0[8 * s2 + 1]); pw.y = cvtpk(s0[8 * s2 + 2], s0[8 * s2 + 3]); pw.z = cvtpk(s0[8 * s2 + 4], s0[8 * s2 + 5]); pw.w = cvtpk(s0[8 * s2 + 6], s0[8 * s2 + 7]); }
                else         { pw.x = cvtpk(s1[8 * s2], s1[8 * s2 + 1]); pw.y = cvtpk(s1[8 * s2 + 2], s1[8 * s2 + 3]); pw.z = cvtpk(s1[8 * s2 + 4], s1[8 * s2 + 5]); pw.w = cvtpk(s1[8 * s2 + 6], s1[8 * s2 + 7]); }
                const bf16x8 pf = __builtin_bit_cast(bf16x8, pw);
                const LAS unsigned char* vb0 = Vb + (32 * kh + 16 * s2) * VSTR + vtoff;
                { const s16x4 lo = vtr(vb0), hi = vtr(vb0 + 8 * VSTR); const bf16x8 vf = __builtin_shufflevector(lo, hi, 0, 1, 2, 3, 4, 5, 6, 7); o0 = MFMA32(vf, pf, o0); }
                { const s16x4 lo = vtr(vb0 + 64), hi = vtr(vb0 + 8 * VSTR + 64); const bf16x8 vf = __builtin_shufflevector(lo, hi, 0, 1, 2, 3, 4, 5, 6, 7); o1 = MFMA32(vf, pf, o1); }
            }
        }
    };
    GLOAD(0, kA0, kA1, vA);
    GLOAD(1, kB0, kB1, vB);
    const int ntm1 = nt - 1;
    for (int t = 0; t < nt; t += 2) {
        const int pb = t & 2;
        LSTORE(pb, kA0, kA1, vA);
        LSTORE(pb + 1, kB0, kB1, vB);
        LDS_BAR();
        { const int tn = (t + 2 < nt) ? t + 2 : ntm1; GLOAD(tn, kA0, kA1, vA); }
        { const int tn = (t + 3 < nt) ? t + 3 : ntm1; GLOAD(tn, kB0, kB1, vB); }
        compute(t, pb);
        compute(t + 1, pb + 1);
    }
#undef GLOAD
#undef LSTORE
    l += SHX(l, 32);
    const float inv = 1.f / l;
    bf16_t* orow = a.O + (size_t)(wrow + r) * a.os + hoff;
#pragma unroll
    for (int g = 0; g < 4; ++g) {
        u32x2 w0, w1; w0.x = cvtpk(o0[4 * g] * inv, o0[4 * g + 1] * inv); w0.y = cvtpk(o0[4 * g + 2] * inv, o0[4 * g + 3] * inv);
        w1.x = cvtpk(o1[4 * g] * inv, o1[4 * g + 1] * inv); w1.y = cvtpk(o1[4 * g + 2] * inv, o1[4 * g + 3] * inv);
        *(u32x2*)(orow + 8 * g + 4 * h) = w0; *(u32x2*)(orow + 32 + 8 * g + 4 * h) = w1;
    }
    __syncthreads();
}
DI void phase_swa(bf16_t* SQ, const bf16_t* SK, const bf16_t* SV, const float* sinkp, const float* qg, bool with_ctx, LAS unsigned char* L, const int WB, bf16_t* OD = nullptr) {
    const int tid = my_tid(); const int nu = 1024 + (with_ctx ? 128 : 0);
    for (int u = (int)((blockIdx.x & 7) * (gridDim.x >> 3) + (blockIdx.x >> 3)); u < nu; u += gridDim.x) {
        AttnU a; a.qs = 512; a.ks = 1024; a.vs = 128; a.os = 512; a.W = 128; a.has_sink = 1; a.qg = qg; a.qrope = 0; a.two = 0; a.sink2 = 0.f;
        if (u < 1024) { const int qb = u & 15, hp = (u >> 4) & 3, b = u >> 6; const int hq = 2 * hp, kvh = hp >> 1; const int q0 = qb * 128;
            a.two = 1; a.qrope = 1; a.sink = sinkp[hq] * LOG2E; a.sink2 = sinkp[hq + 1] * LOG2E; a.q0 = q0; a.kb0 = q0 - 128 < 0 ? 0 : q0 - 128; const int ke = q0 + 256 > LSEQ ? LSEQ : q0 + 256; a.nb = ke - a.kb0; a.na = NC;
            a.Q = SQ + (size_t)(b * LSEQ + q0) * 512 + hq * 64; a.O = SQ + (size_t)(b * LSEQ + q0) * 512 + hq * 64;
            a.KA = SK + (size_t)(NLAT + b * NC) * 1024 + kvh * 64; a.VA = SV + (size_t)(NLAT + b * NC) * 128 + kvh * 64;
            a.KB = SK + (size_t)(b * LSEQ + a.kb0) * 1024 + kvh * 64; a.VB = SV + (size_t)(b * LSEQ + a.kb0) * 128 + kvh * 64;
        } else { const int v = u - 1024; const int hq = v & 7, b = v >> 3; const int kvh = hq >> 2;
            a.sink = sinkp[hq] * LOG2E; a.q0 = 0; a.kb0 = 0; a.nb = 0; a.na = NC;
            a.Q = SQ + (size_t)(NLAT + b * NC) * 512 + hq * 64; a.O = SQ + (size_t)(NLAT + b * NC) * 512 + hq * 64;
            a.KA = SK + (size_t)(NLAT + b * NC) * 1024 + kvh * 64; a.VA = SV + (size_t)(NLAT + b * NC) * 128 + kvh * 64; a.KB = a.KA; a.VB = a.VA;
        }
        if (OD) a.O = OD + (a.O - SQ);
        attn_unit<64>(a, L, tid, WB);
    }
}
DI void phase_mla(bf16_t* QR, const bf16_t* KVR, const float* qg, bool with_ctx, LAS unsigned char* L, const int WB, bf16_t* OD = nullptr) {
    const int tid = my_tid(); const int nu = 1024 + (with_ctx ? 128 : 0);
    for (int u = (int)((blockIdx.x & 7) * (gridDim.x >> 3) + (blockIdx.x >> 3)); u < nu; u += gridDim.x) {
        AttnU a; a.qs = 768; a.ks = 1280; a.vs = 1280; a.os = 768; a.W = 1 << 20; a.has_sink = 0; a.sink = 0.f; a.q0 = 0; a.kb0 = 0; a.na = NC; a.qg = qg; a.qrope = 0; a.two = 0; a.sink2 = 0.f;
        if (u < 1024) { const int qb = u & 7, hh = (u >> 3) & 7, b = u >> 6;
            a.nb = LSEQ; a.q0 = qb * 256; a.qrope = 1; a.Q = QR + (size_t)(b * LSEQ + qb * 256) * 768 + hh * 96; a.O = a.Q ? QR + (size_t)(b * LSEQ + qb * 256) * 768 + hh * 96 : nullptr;
            a.KA = KVR + (size_t)(NLAT + b * NC) * 1280 + hh * 160; a.KB = KVR + (size_t)(b * LSEQ) * 1280 + hh * 160;
        } else { const int v = u - 1024; const int hh = v & 7, b = v >> 3;
            a.nb = 0; a.Q = QR + (size_t)(NLAT + b * NC) * 768 + hh * 96; a.O = QR + (size_t)(NLAT + b * NC) * 768 + hh * 96;
            a.KA = KVR + (size_t)(NLAT + b * NC) * 1280 + hh * 160; a.KB = a.KA;
        }
        a.VA = a.KA + 96; a.VB = a.KB + 96;
        if (OD) a.O = OD + (a.O - QR);
        attn_unit<96>(a, L, tid, WB);
    }
}

struct Args { const float* in[27]; float* out; unsigned char* ws; int ph_lo, ph_hi; };
typedef const __attribute__((address_space(4))) Args* KArgs;
DI KArgs launder(KArgs p) { asm volatile("" : "+s"(p)); return p; }
#define WSP(T, off) ((T*)(A->ws + (off)))
#ifndef PROBE_MASK
#define PROBE_MASK 0
#endif
#ifndef TS_SEL
#define TS_SEL -1
#endif
#define STAMP(id) do { if constexpr (TS_SEL >= 0) { if (blockIdx.x == 0 && my_tid() == 0) { unsigned long long* tsb_ = (unsigned long long*)(A->ws + 32768); \
        const unsigned long long now_ = __builtin_amdgcn_s_memrealtime(); tsb_[1 + (id)] += now_ - tsb_[0]; tsb_[0] = now_; } } } while (0)
DI int opaque_i(int v) { asm volatile("" : "+s"(v)); return v; }
#define REPS(bit) for (int rep_ = 0, nrep_ = (((PROBE_MASK >> (bit)) & 1) ? opaque_i(2) : 1); rep_ < nrep_; ++rep_)
#define PHASE_BEGIN { const KArgs A = launder(ap0); {
#define PHASE_END_ID(id)   GRID_BAR(); if constexpr ((PROBE_MASK >> 9) & 1) GRID_BAR(); STAMP(id); } }
#define PHASE_END_LAST } }
#define LAYER_W(l) LayerW lw; lw.w_in = A->in[7] + (size_t)(l) * 1024 * 2208; lw.w_uq = A->in[9] + (size_t)(l) * 256 * 768; lw.w_ukv = A->in[11] + (size_t)(l) * 128 * 1024; \
        lw.gate_w = A->in[16] + (size_t)(l) * 2 * 2 * 8 * 64 * 64; lw.w_out = A->in[23] + (size_t)(l) * 1536 * 1024; lw.w_ff1 = A->in[25] + (size_t)(l) * 1024 * 4096; lw.w_ff2 = A->in[26] + (size_t)(l) * 4096 * 1024;
#define PHASE_END_MAYBE if (l == 0 || TS_SEL >= 0) GRID_BAR(); STAMP(13); } }
#define XB_TMO      128
#define XB_XCNT(j)  (256  + 64 * (j))
#define XB_XSUB(j)  (1280 + 64 * (j))
#define XB_XGEN(j)  (2304 + 64 * (j))
#define XB_TOP      3328
#define XB_TOPGEN   3392
#define XCD_BAR_WORDS 3456
#define XB_SPIN_CAP (1u << 22)
DI unsigned xb_ld(unsigned* p)              { return __hip_atomic_load(p, __ATOMIC_RELAXED, __HIP_MEMORY_SCOPE_AGENT); }
DI unsigned xb_add(unsigned* p, unsigned v) { return __hip_atomic_fetch_add(p, v, __ATOMIC_RELAXED, __HIP_MEMORY_SCOPE_AGENT); }
DI unsigned xb_xcc_id() { return (unsigned)__builtin_amdgcn_s_getreg((3 << 11) | 20) & 0xFu; }
#define XB_SPIN(cond, bar) do { unsigned _sp = 0; while (cond) { __builtin_amdgcn_s_sleep(1); \
    if ((++_sp & 255u) == 0u) { if (xb_ld(&(bar)[XB_TMO])) break; if (_sp > XB_SPIN_CAP) { atomicAdd(&(bar)[XB_TMO], 1u); break; } } } } while (0)
DI void xcd_barrier_complete(unsigned* bar, unsigned x, unsigned& nloc, unsigned& nx) {
    const unsigned G = gridDim.x * gridDim.y * gridDim.z;
    unsigned sum, cnt, mine, sp = 0u;
    for (;;) {
        sum = 0u; cnt = 0u; mine = 0u;
#pragma unroll
        for (unsigned j = 0; j < 16; ++j) { const unsigned c = xb_ld(&bar[XB_XCNT(j)]); sum += c; cnt += (c > 0u) ? 1u : 0u; mine = (j == x) ? c : mine; }
        if (sum == G) break;
        __builtin_amdgcn_s_sleep(1);
        if ((++sp & 255u) == 0u) { if (xb_ld(&bar[XB_TMO])) break; if (sp > XB_SPIN_CAP) { atomicAdd(&bar[XB_TMO], 1u); break; } }
    }
    nloc = mine > 0u ? mine : 1u; nx = cnt > 0u ? cnt : 1u;
}
DI void grid_bar(unsigned* bar, volatile LAS unsigned* st, const int WB) {
    asm volatile("s_waitcnt vmcnt(0)" ::: "memory");
    __syncthreads();
    if (my_tid() == 0) {
        __builtin_amdgcn_s_waitcnt(0);
        const unsigned x = xb_xcc_id();
        unsigned nloc = st[0], nx = st[1];
        if (nloc == 0u) { xcd_barrier_complete(bar, x, nloc, nx); st[0] = nloc; st[1] = nx; }
        const unsigned old = xb_add(&bar[XB_XSUB(x)], 1u);
        const unsigned gen = old / nloc;
        if (old + 1u == (gen + 1u) * nloc) {
            __builtin_amdgcn_fence(__ATOMIC_RELEASE, "agent");
            asm volatile("s_waitcnt vmcnt(0)" ::: "memory");
            const unsigned og = xb_add(&bar[XB_TOP], 1u);
            const unsigned tg = og / nx;
            if (og + 1u == (tg + 1u) * nx) xb_add(&bar[XB_TOPGEN], 1u);
            else XB_SPIN(xb_ld(&bar[XB_TOPGEN]) == tg, bar);
            __builtin_amdgcn_fence(__ATOMIC_ACQUIRE, "agent");
            xb_add(&bar[XB_XGEN(x)], 1u);
            asm volatile("s_waitcnt vmcnt(0)" ::: "memory");
        } else {
            XB_SPIN(xb_ld(&bar[XB_XGEN(x)]) == gen, bar);
            __builtin_amdgcn_fence(__ATOMIC_ACQUIRE, "agent");
            asm volatile("s_waitcnt vmcnt(0)" ::: "memory");
        }
    }
    __syncthreads();
}
#define GRID_BAR() grid_bar(WSP(unsigned, 0), (volatile LAS unsigned*)(L + LDS_BYTES - 64), WB)
template <int l> DI void run_layer(const KArgs ap0, LAS unsigned char* L, unsigned& nbar, const int WB) {
        PHASE_BEGIN
            if (l == 1) { LAYER_W(1) phase_convert(lw, A->ws + WS_W, L, WB, 2); }
            REPS(0) phase_norm(l == 0 ? A->in[0] : A->out, l == 0 ? A->in[2] : WSP(float, WS_XCRES), l == 0 ? (const bf16_t*)nullptr : WSP(bf16_t, WS_Y2), A->out, WSP(float, WS_XCRES), WSP(bf16_t, WS_HN), A->in[6] + l * 1024, WSP(float, WS_MOD) + (size_t)l * 17 * 6144, 0, NTOK, WB);
        PHASE_END_ID(1)
        PHASE_BEGIN
            pg8::Gemm g{WSP(bf16_t, WS_HN), WSP(bf16_t, WS_W + W_IN), NTOK, PW, 1024, 1024}; pg8::WinOrder<l == 1> S; S.init(gridDim.x, blockIdx.x);
            pg8::EpiStore<0> E{WSP(bf16_t, WS_P), PW, (long long)(WS_LG - WS_P) / 2, 512, 4, 6, (long long)(WS_SQ - WS_P) / 2, 6, 8};
            REPS(1) pg8::gemm_phase<pg8::EpiStore<0>, pg8::WinOrder<l == 1>, true, true>(L, g, S, E, WB);
        PHASE_END_ID(2)
        PHASE_BEGIN
            PrepW pw{A->in[8] + l * 256, A->in[10] + l * 128, A->in[14] + l * 4 * 512, A->in[15] + l * 512, A->in[19] + l * 64, A->in[20] + l * 64};
#ifndef SK_PREP
            REPS(2) phase_prep(WSP(bf16_t, WS_P), pw, WSP(bf16_t, WS_ACT), WSP(bf16_t, WS_KR), WSP(bf16_t, WS_SV), l == 1, WB);
#endif
        PHASE_END_ID(3)
        PHASE_BEGIN
            pg8::Gemm g{WSP(bf16_t, WS_ACT), WSP(bf16_t, WS_W + W_S4), NTOK, 4096, 256, 1024}; pg8::S4Order S; S.init(NTOK, 4096, gridDim.x, blockIdx.x);
            pg8::EpiGate EG{WSP(bf16_t, WS_ACT) + 512, WSP(unsigned, WS_AU), A->in[17] + l * 2048, A->in[18] + l * 1024, NTOK};
            pg8::EpiS4 E{WSP(bf16_t, WS_QR), WSP(bf16_t, WS_KVR), EG, l == 1 ? NLAT : NTOK};
            REPS(3) pg8::gemm_phase<pg8::EpiS4, pg8::S4Order, true, true>(L, g, S, E, WB);
        PHASE_END_ID(4)
        PHASE_BEGIN
            FinW fw{A->in[12] + l * 96, A->in[13] + l * 96};
            phase_finish(WSP(bf16_t, WS_QR), WSP(bf16_t, WS_KVR), WSP(bf16_t, WS_KR), fw, 0, WB);
        PHASE_END_ID(7)
        PHASE_BEGIN
            if (blockIdx.x & 1) {
                phase_scan(WSP(unsigned, WS_AU), L, WB);
                phase_swa(WSP(bf16_t, WS_SQ), WSP(bf16_t, WS_ACT) + 384, WSP(bf16_t, WS_SV), A->in[21] + l * 8, A->in[19] + l * 64, l == 0, L, WB);
                phase_mla(WSP(bf16_t, WS_QR), WSP(bf16_t, WS_KVR), A->in[12] + l * 96, l == 0, L, WB);
            } else {
                phase_mla(WSP(bf16_t, WS_QR), WSP(bf16_t, WS_KVR), A->in[12] + l * 96, l == 0, L, WB);
                phase_swa(WSP(bf16_t, WS_SQ), WSP(bf16_t, WS_ACT) + 384, WSP(bf16_t, WS_SV), A->in[21] + l * 8, A->in[19] + l * 64, l == 0, L, WB);
                phase_scan(WSP(unsigned, WS_AU), L, WB);
            }
        PHASE_END_ID(8)
        PHASE_BEGIN
            REPS(4) phase_groupnorm(WSP(bf16_t, WS_QR), WSP(float, WS_AU), WSP(bf16_t, WS_LG), WSP(bf16_t, WS_SQ), A->in[22] + l * 1536, WSP(bf16_t, WS_ON), l == 1 ? NLAT : NTOK, WB);
        PHASE_END_ID(9)
        PHASE_BEGIN
            const int mrows = l == 1 ? NLAT : NTOK;
            pg8::Gemm g{WSP(bf16_t, WS_ON), WSP(bf16_t, WS_W + W_OUT), mrows, 1024, 1536, 1536}; pg8::StaticOrder S; S.init(mrows, 1024, gridDim.x, blockIdx.x);
            pg8::EpiDelta E{WSP(bf16_t, WS_Y1), WSP(float, WS_MOD) + (size_t)l * 17 * 6144 + 2 * 1024};
            pg8::gemm_phase<pg8::EpiDelta, pg8::StaticOrder, true, true>(L, g, S, E, WB);
            if constexpr (l == 0) { LAYER_W(0) phase_convert(lw, A->ws + WS_W, L, WB, 4); }
        PHASE_END_ID(10)
        PHASE_BEGIN
            phase_norm(l == 0 ? A->in[0] : A->out, l == 0 ? A->in[2] : WSP(float, WS_XCRES), WSP(bf16_t, WS_Y1), A->out, WSP(float, WS_XCRES), WSP(bf16_t, WS_HN), A->in[24] + l * 1024, WSP(float, WS_MOD) + (size_t)l * 17 * 6144, 3, l == 1 ? NLAT : NTOK, WB);
        PHASE_END_ID(11)
        PHASE_BEGIN
            const int mrows = l == 1 ? NLAT : NTOK;
            pg8::Gemm g{WSP(bf16_t, WS_HN), WSP(bf16_t, WS_W + W_FF1), mrows, 4096, 1024, 1024}; pg8::StaticOrder S; S.init(mrows, 4096, gridDim.x, blockIdx.x);
            pg8::EpiStore<2> E{WSP(bf16_t, WS_H), 4096}; REPS(6) pg8::gemm_phase<pg8::EpiStore<2>, pg8::StaticOrder, true, true>(L, g, S, E, WB);
        PHASE_END_ID(12)
        PHASE_BEGIN
            const int mrows = l == 1 ? NLAT : NTOK;
            pg8::Gemm g{WSP(bf16_t, WS_H), WSP(bf16_t, WS_W + W_FF2), mrows, 1024, 4096, 4096}; pg8::StaticOrder S; S.init(mrows, 1024, gridDim.x, blockIdx.x);
            if constexpr (l == 0) {
                pg8::EpiDelta E{WSP(bf16_t, WS_Y2), WSP(float, WS_MOD) + (size_t)l * 17 * 6144 + 5 * 1024};
                pg8::gemm_phase<pg8::EpiDelta, pg8::StaticOrder, true, true>(L, g, S, E, WB);
                { LAYER_W(1) phase_convert(lw, A->ws + WS_W, L, WB, 1); }
            } else {
                pg8::EpiResid E{A->out, WSP(float, WS_XCRES), A->out, WSP(float, WS_XCRES), WSP(float, WS_MOD) + (size_t)l * 17 * 6144 + 5 * 1024};
                pg8::gemm_phase<pg8::EpiResid, pg8::StaticOrder, true, true>(L, g, S, E, WB);
            }
        PHASE_END_MAYBE
}
__global__ void __launch_bounds__(NTHR, 2) fwd_megakernel(Args args_by_value) {
    extern __shared__ __attribute__((aligned(16))) unsigned char lds_raw[];
    LAS unsigned char* L = (LAS unsigned char*)lds_raw;
    cg::grid_group grid = cg::this_grid();
    const KArgs ap0 = (KArgs)__builtin_amdgcn_kernarg_segment_ptr();
    grid.sync();
    const int WB = __builtin_amdgcn_readfirstlane(threadIdx.x);
    unsigned nbar = 0;
    { volatile LAS unsigned* st = (volatile LAS unsigned*)(L + LDS_BYTES - 64); if (tid_from(WB) < 16) st[tid_from(WB)] = 0u; __syncthreads();
      if (tid_from(WB) == 0) (void)xb_add((unsigned*)ap0->ws + XB_XCNT(xb_xcc_id()), 1u); }
    if constexpr (TS_SEL >= 0) { if (blockIdx.x == 0 && tid_from(WB) == 0) { unsigned long long* tsb_ = (unsigned long long*)(ap0->ws + 32768); for (int i = 1; i < 32; ++i) tsb_[i] = 0ull; tsb_[0] = __builtin_amdgcn_s_memrealtime(); } }
    PHASE_BEGIN
#ifndef SK_MOD
        phase_mod(A->in[1], A->in[3], A->in[4], A->in[5], WSP(float, WS_MOD), L, WB);
#endif
        __syncthreads();
        LAYER_W(0)
        phase_convert(lw, A->ws + WS_W, L, WB, 3);
    PHASE_END_ID(0)
    run_layer<0>(ap0, L, nbar, WB);
    run_layer<1>(ap0, L, nbar, WB);
    if constexpr (TS_SEL >= 0) {
        if (blockIdx.x == 0) { const KArgs A = launder(ap0); const unsigned long long* tsb_ = (const unsigned long long*)(A->ws + 32768);
            unsigned long long tot = 0ull; for (int i = 1; i < 32; ++i) tot += tsb_[i];
            const unsigned long long sel = (TS_SEL >= 31) ? tot : tsb_[1 + (TS_SEL >= 31 ? 0 : TS_SEL)];
            const int n = (int)((sel * 65536ull) / tot);
            float* o = A->out; for (int i = tid_from(WB); i < n; i += NTHR) o[i] += 0.125f; }
    }
}
constexpr int N_PHASES = 23;

extern "C" void kernel_launch(void* const* d_in, const int* in_sizes, int n_in, void* d_out, int out_size, void* d_ws, size_t ws_size, hipStream_t stream) {
    static int grid = 0;
    if (grid == 0) {
        if (n_in != 27 || ws_size < WS_END) { fprintf(stderr, "kernel_launch: unexpected n_in %d / ws_size %zu\n", n_in, ws_size); grid = -1; return; }
        int dev = 0, cus = 0, per_cu = 0;
        hipGetDevice(&dev); hipDeviceGetAttribute(&cus, hipDeviceAttributeMultiprocessorCount, dev);
        if (hipFuncSetAttribute((const void*)fwd_megakernel, hipFuncAttributeMaxDynamicSharedMemorySize, LDS_BYTES) != hipSuccess) { fprintf(stderr, "kernel_launch: hipFuncSetAttribute failed\n"); grid = -1; return; }
        if (hipOccupancyMaxActiveBlocksPerMultiprocessor(&per_cu, (const void*)fwd_megakernel, NTHR, LDS_BYTES) != hipSuccess || per_cu < 1) { fprintf(stderr, "kernel_launch: occupancy query says %d\n", per_cu); per_cu = 1; }
        (void)hipGetLastError();
        grid = cus;
        if (grid != 256) { fprintf(stderr, "kernel_launch: needs a 256-CU device (got %d)\n", grid); grid = -1; return; }
    }
    if (grid < 0) return;
    if (hipMemsetAsync(d_ws, 0, 16384, stream) != hipSuccess) { fprintf(stderr, "memset failed\n"); return; }
    Args a{};
    for (int i = 0; i < 27; ++i) a.in[i] = (const float*)d_in[i];
    a.out = (float*)d_out; a.ws = (unsigned char*)d_ws; a.ph_lo = 0; a.ph_hi = N_PHASES;
    void* kargs[] = {&a};
    hipError_t e = hipLaunchCooperativeKernel((const void*)fwd_megakernel, dim3(grid), dim3(NTHR), kargs, LDS_BYTES, stream);
    if (e != hipSuccess) fprintf(stderr, "cooperative launch failed: %s (grid %d)\n", hipGetErrorString(e), grid);
}
```

```cpp
#include <hip/hip_runtime.h>
#include <hip/hip_cooperative_groups.h>
#include <cstdio>
#include <cstdint>
namespace cg = cooperative_groups;
namespace pg8 {
#define PG8_LAS __attribute__((address_space(3)))
typedef unsigned short bf16_t;
typedef short bf16x8 __attribute__((ext_vector_type(8)));
typedef float f32x4 __attribute__((ext_vector_type(4)));
typedef unsigned u32x4 __attribute__((ext_vector_type(4)));
constexpr int BM = 256, BK = 64, HALF = 128, HTB = HALF * BK * 2  , STAGE_BYTES = 8 * HTB, NXCD = 8, WGM = 8;

__host__ __device__ __forceinline__ int lds_byte(int r, int c) { const int st = (r >> 4) * 2 + (c >> 5), rr = r & 15, cc = c & 31, ob = rr * 64 + cc * 2; return st * 1024 + (ob ^ (((ob >> 9) & 1) << 5)); }
__host__ __device__ __forceinline__ void stage_rc(int b, int& R, int& C) { const int st = b / 1024, sb = b % 1024, swz = sb ^ (((sb >> 9) & 1) << 5); R = (st >> 1) * 16 + swz / 64; C = (st & 1) * 32 + (swz % 64) / 2; }
__host__ __device__ __forceinline__ int perm32(int rho) { const int n = rho >> 4, i = rho & 15; return 8 * (i >> 2) + 4 * n + (i & 3); }

struct Unit { int pm, pn, aoff, nt; };
struct Gemm { const bf16_t* A; const bf16_t* Bt; int M, N, K, lda; };

struct StaticOrder {
    int nM, nN, nwg, G, c;
    __host__ __device__ void init(int M, int N, int G_, int c_) { nM = M / BM; nN = N / BM; nwg = nM * nN; G = G_; c = c_; }
    __host__ __device__ bool next(int i, Unit& u) const {
        const long L = (long)i * G + c; if (L >= nwg) return false;
        int wgid = (int)L; { const int q = nwg / NXCD, r = nwg % NXCD, xcd = wgid % NXCD, off = wgid / NXCD; wgid = (xcd < r ? xcd * (q + 1) : r * (q + 1) + (xcd - r) * q) + off; }
        const int nig = WGM * nN, gid = wgid / nig, fm = gid * WGM, gsz = (nM - fm) < WGM ? (nM - fm) : WGM;
        u.pm = fm + ((wgid % nig) % gsz); u.pn = (wgid % nig) / gsz; u.aoff = 0; u.nt = 0; return true;
    }
    __device__ __forceinline__ void a_ready(const Unit&) const {}
    __device__ __forceinline__ void done(const Unit&) const {}
};

__device__ __forceinline__ unsigned cvt_pk_bf16(float lo, float hi) { unsigned r; asm volatile("v_cvt_pk_bf16_f32 %0, %1, %2" : "=v"(r) : "v"(lo), "v"(hi)); return r; }
typedef float f32x2 __attribute__((ext_vector_type(2)));
template <class Epi, class Sched, bool ALIGN_EPI = false, bool SP2 = false>
__device__ __forceinline__ void gemm_phase(PG8_LAS unsigned char* lds, const Gemm g, const Sched& S, const Epi& E, const int WB) {
    int tid_l; asm volatile("v_mbcnt_lo_u32_b32 %0, -1, 0\n\tv_mbcnt_hi_u32_b32 %0, -1, %0\n\tv_add_u32_e32 %0, %1, %0" : "=&v"(tid_l) : "s"(WB)); const int tid = tid_l, wid = __builtin_amdgcn_readfirstlane(tid >> 6), lane = tid & 63, wr = wid >> 2, wc = wid & 3, fr = lane & 15, fq = lane >> 4;
    const int K = g.K, nt_full = K / BK;
    unsigned voffA[2], voffB[2];
#pragma unroll
    for (int i = 0; i < 2; ++i) { int R, C; stage_rc(tid * 16 + i * 8192, R, C); const int Rb = Epi::PERM ? ((R & ~31) + perm32(R & 31)) : R;
        voffA[i] = (unsigned)(R * g.lda + C) * 2u; voffB[i] = (unsigned)(Rb * K + C) * 2u; }
    const size_t kstep = (size_t)(BK * 2);
    const size_t hstepA = (size_t)HALF * g.lda * 2, hstepB = (size_t)HALF * K * 2;
    const size_t tstepA = 2 * hstepA, tstepB = 2 * hstepB;
    const unsigned ldsw = (unsigned)wid * 1024u;
    const int aoff = lds_byte(wr * 64 + fr, fq * 8), boff = lds_byte(wc * 32 + fr, fq * 8);
#define PG8_SA(b, h) (((b) * 2 + (h)) * HTB)
#define PG8_SB(b, h) ((4 + (b) * 2 + (h)) * HTB)
#define PG8_STAGE(bufoff, gbase, voff) do { _Pragma("unroll") for (int _i = 0; _i < 2; ++_i) \
        __builtin_amdgcn_global_load_lds((const unsigned*)((const char*)(gbase) + (voff)[_i]), (PG8_LAS unsigned*)(lds + (bufoff) + ldsw + _i * 8192), 16, 0, 0); } while (0)
#define PG8_LDA(dst, b, h) do { _Pragma("unroll") for (int m = 0; m < 4; ++m) _Pragma("unroll") for (int k = 0; k < 2; ++k) dst[m][k] = *(const PG8_LAS bf16x8*)(lds + PG8_SA(b, h) + aoff + m * 2048 + k * 1024); } while (0)
#define PG8_LDB(dst, b, h) do { _Pragma("unroll") for (int n = 0; n < 2; ++n) _Pragma("unroll") for (int k = 0; k < 2; ++k) dst[n][k] = *(const PG8_LAS bf16x8*)(lds + PG8_SB(b, h) + boff + n * 2048 + k * 1024); } while (0)
#define PG8_MMA(ai, bj, At, Bt) do { __builtin_amdgcn_s_setprio(1); _Pragma("unroll") for (int m = 0; m < 4; ++m) _Pragma("unroll") for (int n = 0; n < 2; ++n) _Pragma("unroll") for (int k = 0; k < 2; ++k) \
        acc[ai][bj][m][n] = __builtin_amdgcn_mfma_f32_16x16x32_bf16(Bt[n][k], At[m][k], acc[ai][bj][m][n], 0, 0, 0); __builtin_amdgcn_s_setprio(0); } while (0)
#define PG8_WAIT_V(n) asm volatile("s_waitcnt vmcnt(" #n ")" ::: "memory")
#define PG8_WAIT_L(n) asm volatile("s_waitcnt lgkmcnt(" #n ")" ::: "memory")
#define PG8_BAR __builtin_amdgcn_s_barrier()
#define PG8_SCHED __builtin_amdgcn_sched_barrier(0)
    Unit cur, nxt; int ui = 0;
    if (!S.next(0, cur)) return;
    f32x4 acc[2][2][4][2];
#pragma unroll
    for (int a = 0; a < 2; ++a)
#pragma unroll
        for (int b = 0; b < 2; ++b)
#pragma unroll
            for (int m = 0; m < 4; ++m)
#pragma unroll
                for (int n = 0; n < 2; ++n) acc[a][b][m][n] = (f32x4){0.f, 0.f, 0.f, 0.f};
    bf16x8 At[4][2], B0[2][2], B1[2][2];
    const char* cA = (const char*)g.A + (size_t)cur.pm * tstepA + cur.aoff; const char* cB = (const char*)g.Bt + (size_t)cur.pn * tstepB;
    S.a_ready(cur);
    if constexpr (SP2) {
        PG8_STAGE(PG8_SB(0, 0), cB, voffB); PG8_STAGE(PG8_SB(0, 1), cB + hstepB, voffB); PG8_STAGE(PG8_SA(0, 0), cA, voffA); PG8_STAGE(PG8_SA(0, 1), cA + hstepA, voffA);
        if (wr == 1) PG8_BAR;
        PG8_WAIT_V(2); PG8_BAR;
        PG8_STAGE(PG8_SB(1, 0), cB + kstep, voffB); PG8_STAGE(PG8_SA(1, 0), cA + kstep, voffA); PG8_STAGE(PG8_SB(1, 1), cB + hstepB + kstep, voffB);
        PG8_WAIT_V(6); PG8_BAR;
    } else {
        PG8_STAGE(PG8_SB(0, 0), cB, voffB); PG8_STAGE(PG8_SA(0, 0), cA, voffA); PG8_STAGE(PG8_SB(0, 1), cB + hstepB, voffB); PG8_STAGE(PG8_SA(0, 1), cA + hstepA, voffA);
        if (wr == 1) PG8_BAR;
        PG8_WAIT_V(4); PG8_BAR;
        PG8_STAGE(PG8_SB(1, 0), cB + kstep, voffB); PG8_STAGE(PG8_SA(1, 0), cA + kstep, voffA); PG8_STAGE(PG8_SB(1, 1), cB + hstepB + kstep, voffB);
        PG8_WAIT_V(6); PG8_BAR;
    }
    for (;;) {
        const bool has_next = S.next(ui + 1, nxt);
        const int nt = cur.nt ? cur.nt : nt_full;
        const char* nA = has_next ? (const char*)g.A + (size_t)nxt.pm * tstepA + nxt.aoff : cA; const char* nB = has_next ? (const char*)g.Bt + (size_t)nxt.pn * tstepB : cB;
        for (int t = 0; t < nt; t += 2) {
            const bool last = (t == nt - 2);
            const char* a1 = cA + (size_t)(t + 1) * kstep;
            const char* a2 = last ? nA : cA + (size_t)(t + 2) * kstep; const char* b2 = last ? nB : cB + (size_t)(t + 2) * kstep;
            const char* a3 = a2 + kstep; const char* b3 = b2 + kstep;
            if (last && has_next) S.a_ready(nxt);
            if constexpr (SP2) {
            PG8_LDB(B0, 0, 0); PG8_LDB(B1, 0, 1); PG8_SCHED; PG8_LDA(At, 0, 0); PG8_STAGE(PG8_SA(1, 1), a1 + hstepA, voffA);
            PG8_WAIT_V(8); PG8_WAIT_L(0); PG8_BAR; PG8_MMA(0, 0, At, B0); PG8_MMA(0, 1, At, B1); PG8_BAR; PG8_SCHED;
            PG8_LDA(At, 0, 1); PG8_STAGE(PG8_SB(0, 0), b2, voffB); PG8_STAGE(PG8_SB(0, 1), b2 + hstepB, voffB); PG8_STAGE(PG8_SA(0, 0), a2, voffA);
            PG8_WAIT_V(8); PG8_WAIT_L(0); PG8_BAR; PG8_MMA(1, 0, At, B0); PG8_MMA(1, 1, At, B1); PG8_BAR; PG8_SCHED;
            PG8_LDB(B0, 1, 0); PG8_LDB(B1, 1, 1); PG8_SCHED; PG8_LDA(At, 1, 0); PG8_STAGE(PG8_SA(0, 1), a2 + hstepA, voffA);
            PG8_WAIT_V(8); PG8_WAIT_L(0); PG8_BAR; PG8_MMA(0, 0, At, B0); PG8_MMA(0, 1, At, B1); PG8_BAR; PG8_SCHED;
            PG8_LDA(At, 1, 1); PG8_STAGE(PG8_SB(1, 0), b3, voffB); PG8_STAGE(PG8_SB(1, 1), b3 + hstepB, voffB); PG8_STAGE(PG8_SA(1, 0), a3, voffA);
            PG8_WAIT_V(8); PG8_WAIT_L(0); PG8_BAR; PG8_MMA(1, 0, At, B0); PG8_MMA(1, 1, At, B1); PG8_BAR; PG8_SCHED;
            } else {
            PG8_LDB(B0, 0, 0); PG8_SCHED; PG8_LDA(At, 0, 0); PG8_STAGE(PG8_SA(1, 1), a1 + hstepA, voffA);
            PG8_WAIT_L(8); PG8_BAR; PG8_WAIT_L(0); PG8_MMA(0, 0, At, B0); PG8_BAR; PG8_SCHED;
            PG8_LDB(B1, 0, 1); PG8_STAGE(PG8_SB(0, 0), b2, voffB);
            PG8_BAR; PG8_WAIT_L(0); PG8_MMA(0, 1, At, B1); PG8_BAR;
            PG8_LDA(At, 0, 1); PG8_STAGE(PG8_SA(0, 0), a2, voffA);
            PG8_BAR; PG8_WAIT_L(0); PG8_MMA(1, 0, At, B0); PG8_BAR; PG8_SCHED;
            PG8_STAGE(PG8_SB(0, 1), b2 + hstepB, voffB);
            PG8_WAIT_V(6); PG8_BAR; PG8_MMA(1, 1, At, B1); PG8_BAR;
            PG8_LDB(B0, 1, 0); PG8_SCHED; PG8_LDA(At, 1, 0); PG8_STAGE(PG8_SA(0, 1), a2 + hstepA, voffA);
            PG8_WAIT_L(8); PG8_BAR; PG8_WAIT_L(0); PG8_MMA(0, 0, At, B0); PG8_BAR; PG8_SCHED;
            PG8_LDB(B1, 1, 1); PG8_STAGE(PG8_SB(1, 0), b3, voffB);
            PG8_BAR; PG8_WAIT_L(0); PG8_MMA(0, 1, At, B1); PG8_BAR;
            PG8_LDA(At, 1, 1); PG8_STAGE(PG8_SA(1, 0), a3, voffA);
            PG8_BAR; PG8_WAIT_L(0); PG8_MMA(1, 0, At, B0); PG8_BAR; PG8_SCHED;
            PG8_STAGE(PG8_SB(1, 1), b3 + hstepB, voffB);
            PG8_WAIT_V(6); PG8_BAR; PG8_MMA(1, 1, At, B1); PG8_BAR;
            }
        }
        if constexpr (ALIGN_EPI) { if (wr == 0) PG8_BAR; }
        if constexpr (!Epi::AFTER_DRAIN) { E(acc, cur, wr, wc, fr, fq); S.done(cur); }
        if (!has_next) break;
#pragma unroll
        for (int a = 0; a < 2; ++a)
#pragma unroll
            for (int b = 0; b < 2; ++b)
#pragma unroll
                for (int m = 0; m < 4; ++m)
#pragma unroll
                    for (int n = 0; n < 2; ++n) acc[a][b][m][n] = (f32x4){0.f, 0.f, 0.f, 0.f};
        cur = nxt; cA = nA; cB = nB; ++ui;
        if constexpr (ALIGN_EPI) { if (wr == 1) PG8_BAR; }
    }
    PG8_WAIT_V(0);
    if constexpr (!ALIGN_EPI) { if (wr == 0) PG8_BAR; }
    PG8_BAR;
    if constexpr (Epi::AFTER_DRAIN) { E.fused(acc, cur, wr, wc, fr, fq, lds, wid, lane); S.done(cur); }
#undef PG8_SA
#undef PG8_SB
#undef PG8_STAGE
#undef PG8_LDA
#undef PG8_LDB
#undef PG8_MMA
#undef PG8_WAIT_V
#undef PG8_WAIT_L
#undef PG8_BAR
#undef PG8_SCHED
}
}
namespace pg8 {
typedef unsigned u32x2v __attribute__((ext_vector_type(2)));
template <bool LAST> struct WinOrder { StaticOrder so; int G, c;
    __host__ __device__ void init(int G_, int c_) { so.init(LAST ? 32768 : 36864, 2304, G_, c_); G = G_; c = c_; }
    __host__ __device__ bool next(int i, Unit& u) const {
        if (!LAST) return so.next(i, u);
        const long L = (long)i * G + c; if (L >= 1280) return false;
        if (L < 1152) return so.next(i, u);
        const int idx = (int)L - 1152; u.pm = 128 + (idx & 15); u.pn = 1 + (idx >> 4); u.aoff = 0; u.nt = 0; return true; }
    __device__ __forceinline__ void a_ready(const Unit&) const {}
    __device__ __forceinline__ void done(const Unit&) const {}
};
struct S4Order { StaticOrder so;
    __host__ __device__ void init(int M, int N, int G_, int c_) { so.init(M, N, G_, c_); }
    __host__ __device__ bool next(int i, Unit& u) const { if (!so.next(i, u)) return false; u.aoff = u.pn < 3 ? 0 : (u.pn < 8 ? 512 : (1024 + 256 * ((u.pn - 8) >> 1))); u.nt = u.pn < 3 ? 0 : 2; return true; }
    __device__ __forceinline__ void a_ready(const Unit&) const {}
    __device__ __forceinline__ void done(const Unit&) const {}
};
template <int ACT> struct EpiStore {
    static constexpr bool PERM = true, AFTER_DRAIN = false;
    bf16_t* O; int ldc; long long d2 = 0; int ldc2 = 0, t0 = 0, t1 = 0; long long d3 = 0; int t2 = 0, t3 = 0;
    __device__ __forceinline__ void operator()(const f32x4 (&acc)[2][2][4][2], const Unit& u, int wr, int wc, int fr, int fq) const {
        const bool alt2 = u.pn >= t0 && u.pn < t1, alt3 = u.pn >= t2 && u.pn < t3, alt = alt2 || alt3; const long long dd = alt2 ? d2 : (alt3 ? d3 : 0ll); bf16_t* O = this->O + dd; const int ldc = alt ? ldc2 : this->ldc;
        const int row0 = u.pm * BM + wr * 64 + fr; const int col0 = (alt2 ? u.pn - t0 : (alt3 ? u.pn - t2 : u.pn)) * BM + wc * 32 + 8 * fq;
#pragma unroll
        for (int ai = 0; ai < 2; ++ai)
#pragma unroll
            for (int m = 0; m < 4; ++m) { bf16_t* rowp = O + (size_t)(row0 + ai * HALF + m * 16) * ldc + col0;
#pragma unroll
                for (int bj = 0; bj < 2; ++bj) { f32x4 v0 = acc[ai][bj][m][0], v1 = acc[ai][bj][m][1];
                    if (ACT == 2) {
#pragma unroll
                        for (int e = 0; e < 4; ++e) { float a = fmaxf(v0[e], 0.f), b = fmaxf(v1[e], 0.f); v0[e] = a * a; v1[e] = b * b; } }
                    u32x4 w; w.x = cvt_pk_bf16(v0[0], v0[1]); w.y = cvt_pk_bf16(v0[2], v0[3]); w.z = cvt_pk_bf16(v1[0], v1[1]); w.w = cvt_pk_bf16(v1[2], v1[3]);
                    *(u32x4*)(rowp + bj * HALF) = w; } }
    }
};
struct EpiDelta {
    static constexpr bool PERM = true, AFTER_DRAIN = false;
    bf16_t* Y; const float* gate;
    __device__ __forceinline__ void operator()(const f32x4 (&acc)[2][2][4][2], const Unit& u, int wr, int wc, int fr, int fq) const {
        const int mr = u.pm < 128 ? (u.pm >> 3) : 16;
        const int row0 = u.pm * BM + wr * 64 + fr; const int col0 = u.pn * BM + wc * 32 + 8 * fq;
        const float* gp = gate + (size_t)mr * 6144 + col0;
        f32x4 g0[2], g1[2];
#pragma unroll
        for (int bj = 0; bj < 2; ++bj) { g0[bj] = *(const f32x4*)(gp + bj * HALF); g1[bj] = *(const f32x4*)(gp + bj * HALF + 4); }
#pragma unroll
        for (int ai = 0; ai < 2; ++ai)
#pragma unroll
            for (int m = 0; m < 4; ++m) { bf16_t* rowp = Y + (size_t)(row0 + ai * HALF + m * 16) * 1024 + col0;
#pragma unroll
                for (int bj = 0; bj < 2; ++bj) { const f32x4 v0 = acc[ai][bj][m][0] * g0[bj], v1 = acc[ai][bj][m][1] * g1[bj];
                    u32x4 w; w.x = cvt_pk_bf16(v0[0], v0[1]); w.y = cvt_pk_bf16(v0[2], v0[3]); w.z = cvt_pk_bf16(v1[0], v1[1]); w.w = cvt_pk_bf16(v1[2], v1[3]);
                    *(u32x4*)(rowp + bj * HALF) = w; } }
    }
};
struct EpiResid {
    static constexpr bool PERM = false, AFTER_DRAIN = false;
    const float* res_lat; const float* res_ctx; float* out_lat; float* out_ctx; const float* gate;
    __device__ __forceinline__ void operator()(const f32x4 (&acc)[2][2][4][2], const Unit& u, int wr, int wc, int fr, int fq) const {
        const bool lat = u.pm < 128; const int mr = lat ? (u.pm >> 3) : 16;
        const float* rb = lat ? res_lat + (size_t)u.pm * BM * 1024 : res_ctx + (size_t)(u.pm - 128) * BM * 1024;
        float* ob = lat ? out_lat + (size_t)u.pm * BM * 1024 : out_ctx + (size_t)(u.pm - 128) * BM * 1024;
        const float* gp = gate + (size_t)mr * 6144;
#pragma unroll
        for (int bj = 0; bj < 2; ++bj)
#pragma unroll
            for (int n = 0; n < 2; ++n) { const int col = u.pn * BM + bj * HALF + wc * 32 + n * 16 + 4 * fq; const f32x4 g = *(const f32x4*)(gp + col);
#pragma unroll
                for (int ai = 0; ai < 2; ++ai)
#pragma unroll
                    for (int m = 0; m < 4; ++m) { const size_t off = (size_t)(ai * HALF + wr * 64 + m * 16 + fr) * 1024 + col;
                        const f32x4 r = *(const f32x4*)(rb + off); *(f32x4*)(ob + off) = r + g * acc[ai][bj][m][n]; } }
    }
};
struct EpiGate {
    static constexpr bool PERM = false, AFTER_DRAIN = false;
    const bf16_t* XC; unsigned* AU; const float* gb; const float* lam; int ntok;
    __device__ __forceinline__ void operator()(const f32x4 (&acc)[2][2][4][2], const Unit& u, int wr, int wc, int fr, int fq) const {
        const int ch = 64 * (u.pn - 8) + 16 * wc + 4 * fq;
#pragma unroll
        for (int z = 0; z < 2; ++z) {
            const f32x4 br = *(const f32x4*)(gb + z * 1024 + ch), bi = *(const f32x4*)(gb + z * 1024 + 512 + ch);
            const f32x4 lm = *(const f32x4*)(lam + z * 512 + ch);
            f32x4 sp;
#pragma unroll
            for (int i = 0; i < 4; ++i) sp[i] = __logf(1.f + __expf(-lm[i])) * (-8.f * 1.4426950408889634f);
#pragma unroll
            for (int ai = 0; ai < 2; ++ai)
#pragma unroll
                for (int m = 0; m < 4; ++m) { const int row = u.pm * BM + ai * HALF + wr * 64 + m * 16 + fr;
                    const unsigned o = (unsigned)row * 512u + (unsigned)ch;
                    const u32x2v xw = *(const u32x2v*)(XC + (unsigned)row * 1024u + (unsigned)ch);
                    float x[4]; x[0] = __uint_as_float(xw.x << 16); x[1] = __uint_as_float(xw.x & 0xffff0000u); x[2] = __uint_as_float(xw.y << 16); x[3] = __uint_as_float(xw.y & 0xffff0000u);
                    const f32x4 vr = acc[ai][z][m][0], vi = acc[ai][z][m][1];
                    u32x4 ov;
#pragma unroll
                    for (int i = 0; i < 4; ++i) {
                        const float rr = __builtin_amdgcn_rcpf(1.f + __expf(-(vr[i] + br[i]))), jj = __builtin_amdgcn_rcpf(1.f + __expf(-(vi[i] + bi[i])));
                        const float la = rr * sp[i];
                        const float uu = __builtin_amdgcn_sqrtf(fmaxf(1.f - __builtin_amdgcn_exp2f(2.f * la), 0.f)) * jj * x[i];
                        ov[i] = cvt_pk_bf16(la, uu); }
                    *(u32x4*)(AU + o + (unsigned)(z * ntok) * 512u) = ov; }
        }
    }
};
struct EpiS4 {
    static constexpr bool PERM = false, AFTER_DRAIN = false;
    bf16_t* QR; bf16_t* KVR; EpiGate G; int q_rows;
    __device__ __forceinline__ void operator()(const f32x4 (&acc)[2][2][4][2], const Unit& u, int wr, int wc, int fr, int fq) const {
        asm volatile("" : "+v"(fr), "+v"(fq));
        if (u.pn >= 8) { G(acc, u, wr, wc, fr, fq); return; }
        const bool isq = u.pn < 3; if (isq && u.pm * BM >= q_rows) return;
        bf16_t* O = isq ? QR : KVR; const int ldc = isq ? 768 : 1280; const int ct = isq ? u.pn : u.pn - 3;
#pragma unroll
        for (int ai = 0; ai < 2; ++ai)
#pragma unroll
            for (int m = 0; m < 4; ++m) { bf16_t* rowp = O + (size_t)(u.pm * BM + ai * HALF + wr * 64 + m * 16 + fr) * ldc + ct * BM + wc * 32 + 4 * fq;
#pragma unroll
                for (int bj = 0; bj < 2; ++bj)
#pragma unroll
                    for (int n = 0; n < 2; ++n) { const f32x4 v = acc[ai][bj][m][n]; u32x2v w; w.x = cvt_pk_bf16(v[0], v[1]); w.y = cvt_pk_bf16(v[2], v[3]); *(u32x2v*)(rowp + bj * HALF + n * 16) = w; } }
    }
};
}
#define DI __device__ __forceinline__
#define LAS __attribute__((address_space(3)))
typedef unsigned short bf16_t;
typedef float f32x4 __attribute__((ext_vector_type(4)));
typedef float f32x2 __attribute__((ext_vector_type(2)));
typedef float f32x16 __attribute__((ext_vector_type(16)));
typedef short bf16x8 __attribute__((ext_vector_type(8)));
typedef short s16x4 __attribute__((ext_vector_type(4)));
typedef unsigned u32x4 __attribute__((ext_vector_type(4)));
typedef unsigned u32x2 __attribute__((ext_vector_type(2)));
typedef __bf16 bf16x2_t __attribute__((ext_vector_type(2)));

constexpr int NB = 16, LSEQ = 2048, NC = 256, DM = 1024, NLAT = NB * LSEQ, NCTX = NB * NC, NTOK = NLAT + NCTX;
constexpr int PW = 2304;
constexpr int C_CQ = 0, C_CKV = 256, C_KR = 384, C_LX = 512, C_LG = 1024, C_SQ = 1536, C_SK = 2048, C_SV = 2176;
constexpr float EPS = 1e-6f, LOG2E = 1.4426950408889634f, LOG2_THETA = 13.287712379549449f;
constexpr int NTHR = 512, NWAVE = 8;
constexpr int LDS_BYTES = 147456;

constexpr size_t MiB = 1u << 20;
constexpr size_t WS_MOD = 131072;
constexpr size_t WS_W = 1 * MiB;
constexpr size_t W_IN = 0, W_S4 = W_IN + (size_t)2304 * 1024 * 2,
                 W_OUT = W_S4 + (size_t)4096 * 256 * 2, W_FF1 = W_OUT + (size_t)1024 * 1536 * 2, W_FF2 = W_FF1 + (size_t)4096 * 1024 * 2, W_END = W_FF2 + (size_t)1024 * 4096 * 2;
static_assert(W_END <= 26 * MiB && WS_MOD + 2 * 17 * 6144 * 4 <= WS_W, "weights");
constexpr size_t WS_XCRES = 27 * MiB;
constexpr size_t WS_R1 = 43 * MiB;
constexpr size_t WS_HN = WS_R1, WS_ACT = WS_R1;
constexpr size_t WS_KVR = 115 * MiB;
constexpr size_t WS_ON = WS_R1;
constexpr size_t WS_P = 205 * MiB;
constexpr size_t WS_AU = WS_P;
constexpr size_t WS_QR = 367 * MiB;
constexpr size_t WS_SQ = 421 * MiB;
constexpr size_t WS_LG = 457 * MiB;
constexpr size_t WS_SV = 493 * MiB;
constexpr size_t WS_KR = 502 * MiB;
constexpr size_t WS_H = 115 * MiB;
constexpr size_t WS_Y1 = 205 * MiB;
constexpr size_t WS_Y2 = 403 * MiB;
constexpr size_t WS_END = 512 * MiB;
static_assert(WS_H + (size_t)NTOK * 4096 * 2 <= WS_LG, "H overlay");

DI int tid_from(int WB) { int t; asm volatile("v_mbcnt_lo_u32_b32 %0, -1, 0\n\tv_mbcnt_hi_u32_b32 %0, -1, %0\n\tv_add_u32_e32 %0, %1, %0" : "=&v"(t) : "s"(WB)); return t; }
#define my_tid() tid_from(WB)
DI float bf2f(bf16_t v) { return __uint_as_float((unsigned)v << 16); }
DI float bflo(unsigned w) { return __uint_as_float(w << 16); }
DI float bfhi(unsigned w) { return __uint_as_float(w & 0xffff0000u); }
DI unsigned cvtpk(float lo, float hi) { f32x2 v = {lo, hi}; bf16x2_t b = __builtin_convertvector(v, bf16x2_t); return __builtin_bit_cast(unsigned, b); }
DI float shx(float v, int o, int lane) { return __int_as_float(__builtin_amdgcn_ds_bpermute((lane ^ o) << 2, __float_as_int(v))); }
#define SHX(v, o) shx((v), (o), lane)
DI float wave_sum_(float v, int lane) {
#pragma unroll
    for (int o = 1; o < 64; o <<= 1) v += SHX(v, o);
    return v;
}
#define wave_sum(v) wave_sum_((v), lane)
DI float sigmoidf_(float x) { return 1.f / (1.f + __expf(-x)); }

DI void phase_mod(const float* c, const float* cctx, const float* w_mod, const float* b_mod, float* MOD, LAS unsigned char* L, const int WB) {
    LAS float* act = (LAS float*)L;
    LAS float* red = (LAS float*)(L + 17 * 1024 * 4);
    const int tid = my_tid(), lane = tid & 63, wave = WB >> 6;
    for (int i = tid; i < 17 * 1024; i += NTHR) { const int r = i >> 10, k = i & 1023; const float v = r < 16 ? c[r * 1024 + k] : cctx[k]; act[i] = v / (1.f + __expf(-v)); }
    __syncthreads();
    for (int item = blockIdx.x; item < 2 * 96; item += gridDim.x) {
        const int l = item / 96, cgp = item % 96, col = cgp * 64 + lane;
        const float* w = w_mod + (size_t)l * 1024 * 6144 + col;
        float acc[17];
#pragma unroll
        for (int r = 0; r < 17; ++r) acc[r] = 0.f;
#pragma unroll 4
        for (int k = wave * 128; k < wave * 128 + 128; ++k) { const float wv = w[(size_t)k * 6144];
#pragma unroll
            for (int r = 0; r < 17; ++r) acc[r] += act[r * 1024 + k] * wv; }
#pragma unroll
        for (int r = 0; r < 17; ++r) red[(wave * 17 + r) * 64 + lane] = acc[r];
        __syncthreads();
        for (int i = tid; i < 17 * 64; i += NTHR) { const int r = i >> 6, cl = i & 63; float s = b_mod[l * 6144 + cgp * 64 + cl];
#pragma unroll
            for (int w8 = 0; w8 < 8; ++w8) s += red[(w8 * 17 + r) * 64 + cl];
            MOD[((size_t)l * 17 + r) * 6144 + cgp * 64 + cl] = s; }
        __syncthreads();
    }
}

DI void transpose_item(const float* W, int K, int N, bf16_t* WT, int k0, int n0, int dst_row0, LAS float* scr, int lane, int ldk = 0) {
    if (ldk == 0) ldk = K;
#pragma unroll 8
    for (int i = 0; i < 32; ++i) { const int kk = 2 * i + (lane >> 5); scr[kk * 33 + (lane & 31)] = W[(size_t)(k0 + kk) * N + n0 + (lane & 31)]; }
    asm volatile("s_waitcnt lgkmcnt(0)" ::: "memory");
    const int c = lane & 7;
#pragma unroll
    for (int j = 0; j < 4; ++j) { const int n = (lane >> 3) + 8 * j; const LAS float* s = scr + (8 * c) * 33 + n;
        u32x4 o; o.x = cvtpk(s[0 * 33], s[1 * 33]); o.y = cvtpk(s[2 * 33], s[3 * 33]); o.z = cvtpk(s[4 * 33], s[5 * 33]); o.w = cvtpk(s[6 * 33], s[7 * 33]);
        *(u32x4*)(WT + (size_t)(dst_row0 + n) * ldk + k0 + 8 * c) = o; }
    asm volatile("s_waitcnt lgkmcnt(0)" ::: "memory");
}
struct LayerW { const float *w_in, *w_uq, *w_ukv, *gate_w, *w_out, *w_ff1, *w_ff2; };
DI void phase_convert(const LayerW& lw, unsigned char* wsw, LAS unsigned char* L, const int WB, const int part = 0) {
    const int tid = my_tid(), lane = tid & 63, wave = WB >> 6;
    LAS float* scr = (LAS float*)(L + wave * 16384);
    const int gw = blockIdx.x * NWAVE + wave, NGW = gridDim.x * NWAVE;
    bf16_t* win_t = (bf16_t*)(wsw + W_IN); bf16_t* ws4 = (bf16_t*)(wsw + W_S4);
    bf16_t* wout_t = (bf16_t*)(wsw + W_OUT); bf16_t* wff1_t = (bf16_t*)(wsw + W_FF1); bf16_t* wff2_t = (bf16_t*)(wsw + W_FF2);
    constexpr int I_IN = 16 * 69, I_UQ = 4 * 24, I_UKV = 2 * 32, I_OUT = 24 * 32, I_F1 = 16 * 128, I_F2 = 64 * 32;
    constexpr int NITEMS = I_IN + I_UQ + I_UKV + I_OUT + I_F1 + I_F2;
    const int it_lo = part == 2 ? NITEMS - I_F2 : (part == 4 ? NITEMS - I_F2 - I_F1 : 0), it_hi = part == 1 ? NITEMS - I_F2 : (part == 3 ? NITEMS - I_F2 - I_F1 : NITEMS);
#pragma unroll 1
    for (int it = it_lo + gw; it < it_hi; it += NGW) {
        int r = it;
        if (r < I_IN) { const int kb = r / 69, nb = r % 69; transpose_item(lw.w_in, 1024, 2208, win_t, 64 * kb, 32 * nb, 32 * nb + (nb >= 13 ? 96 : 0), scr, lane); continue; } r -= I_IN;
        if (r < I_UQ) { const int kb = r / 24, nb = r % 24; transpose_item(lw.w_uq, 256, 768, ws4, 64 * kb, 32 * nb, 32 * nb, scr, lane); continue; } r -= I_UQ;
        if (r < I_UKV) { const int kb = r / 32, nb = r % 32; const int hh = nb >> 2, jb = nb & 3; const int dr = hh * 160 + (jb < 2 ? jb * 32 : 96 + (jb - 2) * 32);
            transpose_item(lw.w_ukv, 128, 1024, ws4, 64 * kb, 32 * nb, 768 + dr, scr, lane, 256); continue; } r -= I_UKV;
        if (r < I_OUT) { const int kb = r / 32, nb = r % 32; transpose_item(lw.w_out, 1536, 1024, wout_t, 64 * kb, 32 * nb, 32 * nb, scr, lane); continue; } r -= I_OUT;
        if (r < I_F1) { const int kb = r / 128, nb = r % 128; transpose_item(lw.w_ff1, 1024, 4096, wff1_t, 64 * kb, 32 * nb, 32 * nb, scr, lane); continue; } r -= I_F1;
        { const int kb = r / 32, nb = r % 32; transpose_item(lw.w_ff2, 4096, 1024, wff2_t, 64 * kb, 32 * nb, 32 * nb, scr, lane); }
    }
    if (part == 2 || part == 4) return;
    const int gt = blockIdx.x * NTHR + tid; constexpr int NGT = 256 * NTHR;
#pragma unroll 1
    for (int i = gt; i < 96 * 1024 / 2; i += NGT) ((unsigned*)(win_t + (size_t)416 * 1024))[i] = 0u;
#pragma unroll 1
    for (int i = gt; i < 1280 * 128; i += NGT) { const int row = i >> 7, k2 = i & 127; const int rr = row % 160; const bool slot = rr >= 64 && rr < 96;
        unsigned* rp = (unsigned*)(ws4 + (size_t)(768 + row) * 256); if (k2 >= 64 || slot) rp[k2] = 0u; }
#pragma unroll 1
    for (int i = gt; i < 4 * 512 * 256; i += NGT) { const int k = i & 255, p = (i >> 8) & 511, j = i >> 17;
        const int pn = p >> 8, z = (p >> 7) & 1, wc = (p >> 5) & 3, g = (p >> 4) & 1, fq = (p >> 2) & 3, ii = p & 3; const int cl = 64 * pn + 16 * wc + 4 * fq + ii;
        float v = 0.f; if (k < 128 && (k >> 6) == (cl >> 6)) { const int blk = 2 * j + (k >> 6); v = lw.gate_w[((((size_t)z * 2 + g) * 8 + blk) * 64 + (k & 63)) * 64 + (cl & 63)]; }
        ws4[(size_t)(2048 + 512 * j + p) * 256 + k] = (bf16_t)(cvtpk(v, 0.f) & 0xffffu); }
}

DI void norm_mod_row(const float* xrow, bf16_t* orow, const float* g, const float* shift, const float* scale, int lane) {
    f32x4 v[4]; float ss = 0.f;
#pragma unroll
    for (int j = 0; j < 4; ++j) { v[j] = *(const f32x4*)(xrow + 4 * lane + 256 * j); ss += (v[j].x * v[j].x + v[j].y * v[j].y) + (v[j].z * v[j].z + v[j].w * v[j].w); }
    const float rstd = rsqrtf(wave_sum(ss) * (1.f / 1024.f) + EPS);
#pragma unroll
    for (int j = 0; j < 4; ++j) { const int col = 4 * lane + 256 * j; const f32x4 gv = *(const f32x4*)(g + col), sh = *(const f32x4*)(shift + col), sc = *(const f32x4*)(scale + col);
        const f32x4 y = v[j] * rstd * gv * (sc + 1.f) + sh; u32x2 o; o.x = cvtpk(y.x, y.y); o.y = cvtpk(y.z, y.w); *(u32x2*)(orow + col) = o; }
}
DI void phase_norm(const float* xlat, const float* xctx, const bf16_t* Y, float* olat, float* octx, bf16_t* HN, const float* g, const float* modl, int chunk, int nrows, const int WB) {
    const int lane = my_tid() & 63, wave = WB >> 6;
    const int gw = blockIdx.x * NWAVE + wave, NGW = gridDim.x * NWAVE;
    for (int r = gw; r < nrows; r += 2 * NGW) {
        const int r2 = r + NGW; const bool has2 = r2 < nrows; const int rb = has2 ? r2 : r;
        const bool latA = r < NLAT, latB = rb < NLAT;
        const float* xa = latA ? xlat + (size_t)r * 1024 : xctx + (size_t)(r - NLAT) * 1024;
        const float* xb = latB ? xlat + (size_t)rb * 1024 : xctx + (size_t)(rb - NLAT) * 1024;
        f32x4 va[4], vb[4]; float sa = 0.f, sb = 0.f;
#pragma unroll
        for (int j = 0; j < 4; ++j) { va[j] = *(const f32x4*)(xa + 4 * lane + 256 * j); vb[j] = *(const f32x4*)(xb + 4 * lane + 256 * j); }
        if (Y) {
            float* oa = latA ? olat + (size_t)r * 1024 : octx + (size_t)(r - NLAT) * 1024;
            float* ob = latB ? olat + (size_t)rb * 1024 : octx + (size_t)(rb - NLAT) * 1024;
#pragma unroll
            for (int j = 0; j < 4; ++j) { const u32x2 ya = *(const u32x2*)(Y + (size_t)r * 1024 + 4 * lane + 256 * j), yb = *(const u32x2*)(Y + (size_t)rb * 1024 + 4 * lane + 256 * j);
                va[j].x += bflo(ya.x); va[j].y += bfhi(ya.x); va[j].z += bflo(ya.y); va[j].w += bfhi(ya.y);
                vb[j].x += bflo(yb.x); vb[j].y += bfhi(yb.x); vb[j].z += bflo(yb.y); vb[j].w += bfhi(yb.y);
                *(f32x4*)(oa + 4 * lane + 256 * j) = va[j]; if (has2) *(f32x4*)(ob + 4 * lane + 256 * j) = vb[j]; }
        }
#pragma unroll
        for (int j = 0; j < 4; ++j) { sa += (va[j].x * va[j].x + va[j].y * va[j].y) + (va[j].z * va[j].z + va[j].w * va[j].w); sb += (vb[j].x * vb[j].x + vb[j].y * vb[j].y) + (vb[j].z * vb[j].z + vb[j].w * vb[j].w); }
#pragma unroll
        for (int o = 1; o < 64; o <<= 1) { sa += SHX(sa, o); sb += SHX(sb, o); }
        const float ra = rsqrtf(sa * (1.f / 1024.f) + EPS), rbs = rsqrtf(sb * (1.f / 1024.f) + EPS);
        const float* ma = modl + (size_t)(latA ? (r >> 11) : 16) * 6144 + chunk * 1024; const float* mb = modl + (size_t)(latB ? (rb >> 11) : 16) * 6144 + chunk * 1024;
#pragma unroll
        for (int j = 0; j < 4; ++j) { const int col = 4 * lane + 256 * j; const f32x4 gv = *(const f32x4*)(g + col);
            { const f32x4 sh = *(const f32x4*)(ma + col), sc = *(const f32x4*)(ma + 1024 + col); const f32x4 y = va[j] * ra * gv * (sc + 1.f) + sh; u32x2 o; o.x = cvtpk(y.x, y.y); o.y = cvtpk(y.z, y.w); *(u32x2*)(HN + (size_t)r * 1024 + col) = o; }
            if (has2) { const f32x4 sh = *(const f32x4*)(mb + col), sc = *(const f32x4*)(mb + 1024 + col); const f32x4 y = vb[j] * rbs * gv * (sc + 1.f) + sh; u32x2 o; o.x = cvtpk(y.x, y.y); o.y = cvtpk(y.z, y.w); *(u32x2*)(HN + (size_t)r2 * 1024 + col) = o; } }
    }
}
DI void load8(const bf16_t* p, float (&v)[8]) { const u32x4 w = *(const u32x4*)p; v[0] = bflo(w.x); v[1] = bfhi(w.x); v[2] = bflo(w.y); v[3] = bfhi(w.y); v[4] = bflo(w.z); v[5] = bfhi(w.z); v[6] = bflo(w.w); v[7] = bfhi(w.w); }
DI void store8(bf16_t* p, const float (&v)[8]) { u32x4 w; w.x = cvtpk(v[0], v[1]); w.y = cvtpk(v[2], v[3]); w.z = cvtpk(v[4], v[5]); w.w = cvtpk(v[6], v[7]); *(u32x4*)p = w; }
DI void head64_norm_rope(float (&v)[8], const float* g, int lane, bool rope, int prow, int pcol, float outscale) {
    const int li = lane & 7;
    float ss = 0.f;
#pragma unroll
    for (int e = 0; e < 8; ++e) ss += v[e] * v[e];
    ss += SHX(ss, 1); ss += SHX(ss, 2); ss += SHX(ss, 4);
    const float rstd = rsqrtf(ss * (1.f / 64.f) + EPS);
    const int axis = li >> 2, half = (li >> 1) & 1; const float pos = (float)(axis ? pcol : prow);
#pragma unroll
    for (int e = 0; e < 8; ++e) v[e] = v[e] * rstd * g[8 * li + e];
#pragma unroll
    for (int e = 0; e < 8; ++e) { const float p = SHX(v[e], 2);
        if (rope) { const int i = 8 * (li & 1) + e; const float ang = pos * __builtin_amdgcn_exp2f(-(float)i * (LOG2_THETA / 16.f));
            const float cs = __cosf(ang), sn = __sinf(ang); const float rot = half ? p : -p; v[e] = v[e] * cs + rot * sn; } }
#pragma unroll
    for (int e = 0; e < 8; ++e) v[e] *= outscale;
}
struct PrepW { const float *q_a_g, *kv_a_g, *conv_w, *conv_b, *swa_q_g, *swa_k_g; };
DI void phase_prep(const bf16_t* __restrict__ P, const PrepW& w, bf16_t* __restrict__ ACT, bf16_t* __restrict__ KR, bf16_t* __restrict__ SV, bool last, const int WB) {
    const int lane = my_tid() & 63, wave = WB >> 6;
    const int gw = blockIdx.x * NWAVE + wave, NGW = gridDim.x * NWAVE;
    const f32x4 gq = *(const f32x4*)(w.q_a_g + 4 * lane);
    const float gkv0 = w.kv_a_g[2 * lane], gkv1 = w.kv_a_g[2 * lane + 1];
    float cw[4][8], cb[8], gk[8], frq[8];
    const int li = lane & 7, l16 = lane & 15; const int axis = li >> 2; const bool half = (li >> 1) & 1;
#pragma unroll
    for (int e = 0; e < 8; ++e) { cb[e] = w.conv_b[8 * lane + e]; gk[e] = w.swa_k_g[8 * li + e]; frq[e] = __builtin_amdgcn_exp2f(-(float)(8 * (li & 1) + e) * (LOG2_THETA / 16.f));
#pragma unroll
        for (int t = 0; t < 4; ++t) cw[t][e] = w.conv_w[t * 512 + 8 * lane + e]; }
    for (int r0 = gw; r0 < NTOK; r0 += 2 * NGW) {
        int rr[2]; bool lat[2]; int pos[2];
        u32x2 cqv[2]; unsigned ckvv[2], krv[2]; u32x4 lxv[2][4], skv[2], svv[2]; float msk[2][4];
#pragma unroll
        for (int k = 0; k < 2; ++k) {
            int r = r0 + k * NGW; if (r >= NTOK) r = r0;
            rr[k] = r; lat[k] = r < NLAT; pos[k] = lat[k] ? (r & (LSEQ - 1)) : ((r - NLAT) & (NC - 1)); const int slen = lat[k] ? LSEQ : NC;
            const bf16_t* pr = P + (size_t)r * PW;
            cqv[k] = *(const u32x2*)(pr + C_CQ + 4 * lane); ckvv[k] = *(const unsigned*)(pr + C_CKV + 2 * lane); krv[k] = *(const unsigned*)(pr + C_KR + 2 * l16);
#pragma unroll
            for (int t = 0; t < 4; ++t) { const int pp = pos[k] + t - 2; const bool ok = pp >= 0 && pp < slen; msk[k][t] = ok ? 1.f : 0.f;
                lxv[k][t] = *(const u32x4*)(pr + (ptrdiff_t)(ok ? t - 2 : 0) * PW + C_LX + 8 * lane); }
            skv[k] = *(const u32x4*)(pr + C_SK + 8 * l16); svv[k] = *(const u32x4*)(pr + C_SV + 8 * l16);
        }
        float a[2][4], bq[2][2], sq_[2], sk_[2], kv[2][8], s8[2];
#pragma unroll
        for (int k = 0; k < 2; ++k) {
            a[k][0] = bflo(cqv[k].x); a[k][1] = bfhi(cqv[k].x); a[k][2] = bflo(cqv[k].y); a[k][3] = bfhi(cqv[k].y);
            sq_[k] = (a[k][0] * a[k][0] + a[k][1] * a[k][1]) + (a[k][2] * a[k][2] + a[k][3] * a[k][3]);
            bq[k][0] = bflo(ckvv[k]); bq[k][1] = bfhi(ckvv[k]); sk_[k] = bq[k][0] * bq[k][0] + bq[k][1] * bq[k][1];
            kv[k][0] = bflo(skv[k].x); kv[k][1] = bfhi(skv[k].x); kv[k][2] = bflo(skv[k].y); kv[k][3] = bfhi(skv[k].y); kv[k][4] = bflo(skv[k].z); kv[k][5] = bfhi(skv[k].z); kv[k][6] = bflo(skv[k].w); kv[k][7] = bfhi(skv[k].w);
            s8[k] = 0.f;
#pragma unroll
            for (int e = 0; e < 8; ++e) s8[k] += kv[k][e] * kv[k][e];
        }
#pragma unroll
        for (int o = 1; o < 64; o <<= 1) { sq_[0] += SHX(sq_[0], o); sq_[1] += SHX(sq_[1], o); sk_[0] += SHX(sk_[0], o); sk_[1] += SHX(sk_[1], o);
            if (o < 8) { s8[0] += SHX(s8[0], o); s8[1] += SHX(s8[1], o); } }
#pragma unroll
        for (int k = 0; k < 2; ++k) {
            const int r = rr[k]; bf16_t* arow = ACT + (size_t)r * 1024;
            {
                const float rstd = rsqrtf(sq_[k] * (1.f / 256.f) + EPS);
                u32x2 o; o.x = cvtpk(a[k][0] * rstd * gq.x, a[k][1] * rstd * gq.y); o.y = cvtpk(a[k][2] * rstd * gq.z, a[k][3] * rstd * gq.w);
                if (last && !lat[k]) { o.x = 0u; o.y = 0u; }
                *(u32x2*)(arow + 4 * lane) = o; }
            {
                const float rstd = rsqrtf(sk_[k] * (1.f / 128.f) + EPS);
                *(unsigned*)(arow + 256 + 2 * lane) = cvtpk(bq[k][0] * rstd * gkv0, bq[k][1] * rstd * gkv1); }
            if (lane < 16) *(unsigned*)(KR + (size_t)r * 32 + 2 * lane) = krv[k];
            {
                float acc[8];
#pragma unroll
                for (int e = 0; e < 8; ++e) acc[e] = cb[e];
#pragma unroll
                for (int t = 0; t < 4; ++t) { const u32x4 xw = lxv[k][t]; const float mm = msk[k][t];
                    const float xv[8] = {bflo(xw.x), bfhi(xw.x), bflo(xw.y), bfhi(xw.y), bflo(xw.z), bfhi(xw.z), bflo(xw.w), bfhi(xw.w)};
#pragma unroll
                    for (int e = 0; e < 8; ++e) acc[e] += (xv[e] * mm) * cw[t][e]; }
                store8(arow + 512 + 8 * lane, acc); }
            {
                const float rstd = rsqrtf(s8[k] * (1.f / 64.f) + EPS); const float pa = (float)(axis ? (pos[k] & 63) : (pos[k] >> 6));
                float v[8];
#pragma unroll
                for (int e = 0; e < 8; ++e) v[e] = kv[k][e] * rstd * gk[e];
#pragma unroll
                for (int e = 0; e < 8; ++e) { const float p = SHX(v[e], 2);
                    if (lat[k]) { const float ang = pa * frq[e]; const float cs = __cosf(ang), sn = __sinf(ang); const float rot = half ? p : -p; v[e] = v[e] * cs + rot * sn; } }
                if (lane < 16) { store8(arow + 384 + 8 * lane, v); *(u32x4*)(SV + (size_t)r * 128 + 8 * lane) = svv[k]; } }
        }
    }
}

struct FinW { const float *mla_q_g, *mla_k_g; };
DI void load4(const bf16_t* p, float (&v)[4]) { const u32x2 w = *(const u32x2*)p; v[0] = bflo(w.x); v[1] = bfhi(w.x); v[2] = bflo(w.y); v[3] = bfhi(w.y); }
DI void store4(bf16_t* p, const float (&v)[4]) { u32x2 w; w.x = cvtpk(v[0], v[1]); w.y = cvtpk(v[2], v[3]); *(u32x2*)p = w; }
DI void head96_finish(float (&a)[8], float (&b)[4], const float (&g8)[8], const float (&g4)[4], const float (&cs)[4], const float (&sn)[4], bool half, float osc, int lane) {
    float ss = 0.f;
#pragma unroll
    for (int e = 0; e < 8; ++e) ss += a[e] * a[e];
#pragma unroll
    for (int e = 0; e < 4; ++e) ss += b[e] * b[e];
    ss += SHX(ss, 1); ss += SHX(ss, 2); ss += SHX(ss, 4);
    const float rstd = rsqrtf(ss * (1.f / 96.f) + EPS) ;
#pragma unroll
    for (int e = 0; e < 8; ++e) a[e] = a[e] * rstd * g8[e] * osc;
#pragma unroll
    for (int e = 0; e < 4; ++e) b[e] = b[e] * rstd * g4[e];
#pragma unroll
    for (int e = 0; e < 4; ++e) { const float p = SHX(b[e], 2); const float rot = half ? p : -p; b[e] = (b[e] * cs[e] + rot * sn[e]) * osc; }
}
DI void phase_finish(bf16_t* QR, bf16_t* KVR, const bf16_t* KR, const FinW& w, int nq_rows, const int WB) {
    const int lane = my_tid() & 63, wave = WB >> 6;
    const int gw = blockIdx.x * NWAVE + wave, NGW = gridDim.x * NWAVE;
    const int hh = lane >> 3, li = lane & 7;
    const int axis = li >> 2; const bool half = (li >> 1) & 1;
    float fr[4], gq8[8], gq4[4], gk8[8], gk4[4];
#pragma unroll
    for (int e = 0; e < 4; ++e) { fr[e] = __builtin_amdgcn_exp2f(-(float)(4 * (li & 1) + e) * (LOG2_THETA / 8.f)); gq4[e] = w.mla_q_g[64 + 4 * li + e]; gk4[e] = w.mla_k_g[64 + 4 * li + e]; }
#pragma unroll
    for (int e = 0; e < 8; ++e) { gq8[e] = w.mla_q_g[8 * li + e]; gk8[e] = w.mla_k_g[8 * li + e]; }
    if (nq_rows > 0) {
        for (int r = gw; r < nq_rows; r += NGW) {
            const bool lat = r < NLAT; const int pos = r & (LSEQ - 1); const float pa = (float)(axis ? (pos & 63) : (pos >> 6));
            float cs[4], sn[4];
#pragma unroll
            for (int e = 0; e < 4; ++e) { cs[e] = lat ? __cosf(pa * fr[e]) : 1.f; sn[e] = lat ? __sinf(pa * fr[e]) : 0.f; }
            bf16_t* qp = QR + (size_t)r * 768 + hh * 96; float a[8], b[4]; load8(qp + 8 * li, a); load4(qp + 64 + 4 * li, b);
            head96_finish(a, b, gq8, gq4, cs, sn, half, 0.10206207261596575f * LOG2E, lane);
            store8(qp + 8 * li, a); store4(qp + 64 + 4 * li, b);
        }
    }
    for (int r0 = gw; r0 < NTOK; r0 += 6 * NGW) {
        u32x4 av[6]; u32x2 bv[6]; int rr[6];
#pragma unroll
        for (int k = 0; k < 6; ++k) { int r = r0 + k * NGW; if (r >= NTOK) r = r0; rr[k] = r;
            av[k] = *(const u32x4*)(KVR + (size_t)r * 1280 + hh * 160 + 8 * li); bv[k] = *(const u32x2*)(KR + (size_t)r * 32 + 4 * li); }
        float a[6][8], b[6][4], ss[6];
#pragma unroll
        for (int k = 0; k < 6; ++k) { const u32x4 w4 = av[k]; const u32x2 w2 = bv[k];
            a[k][0] = bflo(w4.x); a[k][1] = bfhi(w4.x); a[k][2] = bflo(w4.y); a[k][3] = bfhi(w4.y); a[k][4] = bflo(w4.z); a[k][5] = bfhi(w4.z); a[k][6] = bflo(w4.w); a[k][7] = bfhi(w4.w);
            b[k][0] = bflo(w2.x); b[k][1] = bfhi(w2.x); b[k][2] = bflo(w2.y); b[k][3] = bfhi(w2.y);
            ss[k] = 0.f;
#pragma unroll
            for (int e = 0; e < 8; ++e) ss[k] += a[k][e] * a[k][e];
#pragma unroll
            for (int e = 0; e < 4; ++e) ss[k] += b[k][e] * b[k][e]; }
#pragma unroll
        for (int o = 1; o < 8; o <<= 1) {
#pragma unroll
            for (int k = 0; k < 6; ++k) ss[k] += SHX(ss[k], o); }
#pragma unroll
        for (int k = 0; k < 6; ++k) {
            const int r = rr[k]; const bool lat = r < NLAT; const int pos = r & (LSEQ - 1); const float pa = (float)(axis ? (pos & 63) : (pos >> 6));
            const float rstd = rsqrtf(ss[k] * (1.f / 96.f) + EPS);
#pragma unroll
            for (int e = 0; e < 8; ++e) a[k][e] = a[k][e] * rstd * gk8[e];
#pragma unroll
            for (int e = 0; e < 4; ++e) b[k][e] = b[k][e] * rstd * gk4[e];
#pragma unroll
            for (int e = 0; e < 4; ++e) { const float p = SHX(b[k][e], 2);
                if (lat) { const float ang = pa * fr[e]; const float cs = __cosf(ang), sn = __sinf(ang); const float rot = half ? p : -p; b[k][e] = b[k][e] * cs + rot * sn; } }
            bf16_t* kp = KVR + (size_t)r * 1280 + hh * 160;
            store8(kp + 8 * li, a[k]); store4(kp + 64 + 4 * li, b[k]);
        }
    }
}

DI int scan_row(int b, int dir, int s) {
    if (s < NC) return NLAT + b * NC + (dir ? (NC - 1 - s) : s);
    const int l = s - NC; return b * LSEQ + (dir ? (LSEQ - 1 - l) : l);
}
DI void phase_scan(unsigned* AU, LAS unsigned char* L, const int WB) {
    LAS float* sA = (LAS float*)L; LAS float* sH = (LAS float*)(L + 2048);
    const int tid = my_tid(), ch = tid & 15, seg = tid >> 4;
    for (int u = (int)((blockIdx.x & 7) * (gridDim.x >> 3) + (blockIdx.x >> 3)); u < NB * 32; u += gridDim.x) {
        const int cgp = u & 31, b = u >> 5;
#pragma unroll 1
        for (int dir = 0; dir < 2; ++dir) {
            unsigned* base = AU + (size_t)dir * NTOK * 512 + cgp * 16 + ch;
            float* sum = (float*)(AU + cgp * 16 + ch);
            unsigned wv[72];
            const int s0 = seg * 72;
            const int dstride = dir ? -512 : 512;
            const int jump = (scan_row(b, dir, 256) - scan_row(b, dir, 255)) * 512;
            const unsigned idx0 = (unsigned)scan_row(b, dir, s0) * 512u;
            unsigned idx = idx0;
#pragma unroll
            for (int s = 0; s < 72; ++s) { wv[s] = base[idx]; idx += (unsigned)((s0 + s == 255) ? jump : dstride); asm volatile("" : "+v"(idx)); }
            float A = 1.f, H = 0.f;
#pragma unroll
            for (int s = 0; s < 72; ++s) { const float a = __builtin_amdgcn_exp2f(bflo(wv[s])), uu = bfhi(wv[s]); H = a * H + uu; A *= a; }
            sA[seg * 16 + ch] = A; sH[seg * 16 + ch] = H;
            __syncthreads();
            float h = 0.f;
            for (int s2 = 0; s2 < seg; ++s2) h = sA[s2 * 16 + ch] * h + sH[s2 * 16 + ch];
            idx = idx0;
            if (dir == 0) {
#pragma unroll
                for (int s = 0; s < 72; ++s) { const float a = __builtin_amdgcn_exp2f(bflo(wv[s])), uu = bfhi(wv[s]); h = a * h + uu; sum[idx] = h; idx += (unsigned)((s0 + s == 255) ? jump : dstride); asm volatile("" : "+v"(idx)); }
            } else {
                float hf[72];
#pragma unroll
                for (int s = 0; s < 72; ++s) { hf[s] = sum[idx]; idx += (unsigned)((s0 + s == 255) ? jump : dstride); asm volatile("" : "+v"(idx)); }
                idx = idx0;
#pragma unroll
                for (int s = 0; s < 72; ++s) { const float a = __builtin_amdgcn_exp2f(bflo(wv[s])), uu = bfhi(wv[s]); h = a * h + uu; sum[idx] = hf[s] + h; idx += (unsigned)((s0 + s == 255) ? jump : dstride); asm volatile("" : "+v"(idx)); }
            }
            __syncthreads();
        }
    }
}

DI float gelu_tanh(float x) { const float z = 0.7978845608028654f * (x + 0.044715f * x * x * x); const float t = 1.f - 2.f * __builtin_amdgcn_rcpf(1.f + __expf(2.f * z)); return 0.5f * x * (1.f + t); }
DI void group_out(float (&v)[8], const float* g, bf16_t* dst, int lane) {
    float ss = 0.f;
#pragma unroll
    for (int e = 0; e < 8; ++e) ss += v[e] * v[e];
    const float rstd = rsqrtf(wave_sum(ss) * (1.f / 512.f) + EPS);
#pragma unroll
    for (int e = 0; e < 8; ++e) v[e] = v[e] * rstd * g[e];
    store8(dst, v);
}
DI void phase_groupnorm(const bf16_t* OA, const float* HS, const bf16_t* LG, const bf16_t* OC, const float* gg, bf16_t* ON, int nrows, const int WB) {
    const int lane = my_tid() & 63, wave = WB >> 6;
    const int gw = blockIdx.x * NWAVE + wave, NGW = gridDim.x * NWAVE;
    for (int r = gw; r < nrows; r += NGW) {
        float v[8];
        load8(OA + (size_t)r * 768 + (lane >> 3) * 96 + (lane & 7) * 8, v);
        group_out(v, gg + 8 * lane, ON + (size_t)r * 1536 + 8 * lane, lane);
        float lg[8]; load8(LG + (size_t)r * 512 + 8 * lane, lg);
        const f32x4 f0 = *(const f32x4*)(HS + (size_t)r * 512 + 8 * lane), f1 = *(const f32x4*)(HS + (size_t)r * 512 + 8 * lane + 4);
#pragma unroll
        for (int e = 0; e < 4; ++e) { v[e] = f0[e] * gelu_tanh(lg[e]); v[4 + e] = f1[e] * gelu_tanh(lg[4 + e]); }
        group_out(v, gg + 512 + 8 * lane, ON + (size_t)r * 1536 + 512 + 8 * lane, lane);
        load8(OC + (size_t)r * 512 + 8 * lane, v);
        group_out(v, gg + 1024 + 8 * lane, ON + (size_t)r * 1536 + 1024 + 8 * lane, lane);
    }
}
struct AttnU { const bf16_t *Q, *KA, *KB, *VA, *VB; bf16_t* O; int qs, ks, vs, os, na, nb, kb0, q0, W; float sink; int has_sink; const float* qg; int qrope; int two; float sink2; };
#define MFMA32(a, b, c) __builtin_amdgcn_mfma_f32_32x32x16_bf16((a), (b), (c), 0, 0, 0)
#define LDS_BAR() do { asm volatile("s_waitcnt lgkmcnt(0)" ::: "memory"); __builtin_amdgcn_s_barrier(); asm volatile("" ::: "memory"); } while (0)
typedef short v4i16_t __attribute__((ext_vector_type(4)));
DI float max3f(float a, float b, float c) { float r; asm("v_max3_f32 %0, %1, %2, %3" : "=v"(r) : "v"(a), "v"(b), "v"(c)); return r; }
DI float max2f(float a, float b) { float r; asm("v_max_f32_e32 %0, %1, %2" : "=v"(r) : "v"(a), "v"(b)); return r; }
DI s16x4 vtr(const LAS unsigned char* p) { return __builtin_bit_cast(s16x4, __builtin_amdgcn_ds_read_tr16_b64_v4i16((LAS v4i16_t*)p)); }
template <int DQ> DI void attn_unit(const AttnU& a, LAS unsigned char* L, int tid, const int WB) {
    constexpr int KSTR = DQ * 2 + 16, VSTR = 144, KBUF = 64 * KSTR, VBUF = 64 * VSTR, NS = DQ / 16, CPR = DQ / 8, NCH = 64 * CPR;
    const int lane = tid & 63, wave = WB >> 6, r = lane & 31, h = lane >> 5;
    const int wrow = a.two ? (wave & 3) * 32 : wave * 32, hoff = a.two ? (wave >> 2) * 64 : 0;
    bf16x8 qf[NS];
    { const bf16_t* qrow = a.Q + (size_t)(wrow + r) * a.qs + hoff + 8 * h;
#pragma unroll
      for (int s = 0; s < NS; ++s) qf[s] = *(const bf16x8*)(qrow + 16 * s); }
    if constexpr (DQ == 96) {
        if (a.qg) {
            float qv[NS][8]; float ss = 0.f;
#pragma unroll
            for (int s = 0; s < NS; ++s) { const u32x4 w = __builtin_bit_cast(u32x4, qf[s]);
                qv[s][0] = bflo(w.x); qv[s][1] = bfhi(w.x); qv[s][2] = bflo(w.y); qv[s][3] = bfhi(w.y); qv[s][4] = bflo(w.z); qv[s][5] = bfhi(w.z); qv[s][6] = bflo(w.w); qv[s][7] = bfhi(w.w);
#pragma unroll
                for (int j = 0; j < 8; ++j) ss += qv[s][j] * qv[s][j]; }
            ss += SHX(ss, 32);
            const float rs = rsqrtf(ss * (1.f / 96.f) + EPS);
#pragma unroll
            for (int s = 0; s < NS; ++s)
#pragma unroll
                for (int j = 0; j < 8; ++j) qv[s][j] *= rs * a.qg[16 * s + 8 * h + j];
            const int pos = a.q0 + wrow + r;
#pragma unroll
            for (int s = 4; s < 6; ++s) { const float pa = (float)(s == 4 ? (pos >> 6) : (pos & 63));
#pragma unroll
                for (int j = 0; j < 8; ++j) { const float p = SHX(qv[s][j], 32);
                    if (a.qrope) { const float ang = pa * __builtin_amdgcn_exp2f(-(float)j * (LOG2_THETA / 8.f)); const float cs = __cosf(ang), sn = __sinf(ang); const float rot = h ? p : -p; qv[s][j] = qv[s][j] * cs + rot * sn; } } }
            const float qsc = 0.10206207261596575f * LOG2E;
#pragma unroll
            for (int s = 0; s < NS; ++s) { u32x4 w; w.x = cvtpk(qv[s][0] * qsc, qv[s][1] * qsc); w.y = cvtpk(qv[s][2] * qsc, qv[s][3] * qsc); w.z = cvtpk(qv[s][4] * qsc, qv[s][5] * qsc); w.w = cvtpk(qv[s][6] * qsc, qv[s][7] * qsc);
                qf[s] = __builtin_bit_cast(bf16x8, w); }
        }
    }
    if constexpr (DQ == 64) {
        if (a.qg) {
            float qv[NS][8]; float ss = 0.f;
#pragma unroll
            for (int s = 0; s < NS; ++s) { const u32x4 w = __builtin_bit_cast(u32x4, qf[s]);
                qv[s][0] = bflo(w.x); qv[s][1] = bfhi(w.x); qv[s][2] = bflo(w.y); qv[s][3] = bfhi(w.y); qv[s][4] = bflo(w.z); qv[s][5] = bfhi(w.z); qv[s][6] = bflo(w.w); qv[s][7] = bfhi(w.w);
#pragma unroll
                for (int j = 0; j < 8; ++j) ss += qv[s][j] * qv[s][j]; }
            ss += SHX(ss, 32);
            const float rs = rsqrtf(ss * (1.f / 64.f) + EPS);
#pragma unroll
            for (int s = 0; s < NS; ++s)
#pragma unroll
                for (int j = 0; j < 8; ++j) qv[s][j] *= rs * a.qg[16 * s + 8 * h + j];
            if (a.qrope) {
                const int pos = a.q0 + wrow + r;
#pragma unroll
                for (int ax = 0; ax < 2; ++ax) { const float pa = (float)(ax == 0 ? (pos >> 6) : (pos & 63));
#pragma unroll
                    for (int j = 0; j < 8; ++j) { const float ang = pa * __builtin_amdgcn_exp2f(-(float)(8 * h + j) * (LOG2_THETA / 16.f)); const float cs = __cosf(ang), sn = __sinf(ang);
                        const float lo = qv[2 * ax][j], hi = qv[2 * ax + 1][j]; qv[2 * ax][j] = lo * cs - hi * sn; qv[2 * ax + 1][j] = hi * cs + lo * sn; } }
            }
            const float qsc = 0.125f * LOG2E;
#pragma unroll
            for (int s = 0; s < NS; ++s) { u32x4 w; w.x = cvtpk(qv[s][0] * qsc, qv[s][1] * qsc); w.y = cvtpk(qv[s][2] * qsc, qv[s][3] * qsc); w.z = cvtpk(qv[s][4] * qsc, qv[s][5] * qsc); w.w = cvtpk(qv[s][6] * qsc, qv[s][7] * qsc);
                qf[s] = __builtin_bit_cast(bf16x8, w); }
        }
    }
    f32x16 o0, o1;
#pragma unroll
    for (int i = 0; i < 16; ++i) { o0[i] = 0.f; o1[i] = 0.f; }
    float m = a.has_sink ? ((a.two && wave >= 4) ? a.sink2 : a.sink) : 0.f, l = (a.has_sink && h == 0) ? 1.f : 0.f;
    f32x16 negm;
#pragma unroll
    for (int i = 0; i < 16; ++i) negm[i] = -m;
    const int nt = (a.na + a.nb) >> 6;
    const int c0r = tid / CPR, c0c = tid % CPR, c1r = (tid + 512) / CPR, c1c = (tid + 512) % CPR, vkey = tid >> 3, vc = tid & 7;
    u32x4 kA0, kA1 = {0u, 0u, 0u, 0u}, vA, kB0, kB1 = {0u, 0u, 0u, 0u}, vB;
#define GLOAD(t, K0, K1, VV) do { const int k0_ = (t) * 64; const bf16_t* kp_; const bf16_t* vp_; \
        if (k0_ < a.na) { kp_ = a.KA + (size_t)k0_ * a.ks; vp_ = a.VA + (size_t)k0_ * a.vs; } else { kp_ = a.KB + (size_t)(k0_ - a.na) * a.ks; vp_ = a.VB + (size_t)(k0_ - a.na) * a.vs; } \
        K0 = *(const u32x4*)(kp_ + (size_t)c0r * a.ks + c0c * 8); \
        if (NCH > 512) { if (tid < NCH - 512) K1 = *(const u32x4*)(kp_ + (size_t)c1r * a.ks + c1c * 8); } \
        VV = *(const u32x4*)(vp_ + (size_t)vkey * a.vs + vc * 8); } while (0)
#define LSTORE(buf, K0, K1, VV) do { *(LAS u32x4*)(L + (buf) * KBUF + c0r * KSTR + c0c * 16) = K0; \
        if (NCH > 512) { if (tid < NCH - 512) *(LAS u32x4*)(L + (buf) * KBUF + c1r * KSTR + c1c * 16) = K1; } \
        *(LAS u32x4*)(L + 4 * KBUF + (buf) * VBUF + vkey * VSTR + vc * 16) = VV; } while (0)
    const int iq = a.q0 + wrow + r, iq0 = a.q0 + wrow;
    const int i16 = lane & 15, tq = i16 >> 2, tp = i16 & 3, tblk = (lane >> 4) & 1;
    const int vtoff = (4 * h + tq) * VSTR + 8 * (4 * tblk + tp);
    auto compute = [&](int t, int buf) {
        const int k0 = t * 64; const bool masked = (k0 >= a.na) && (a.W < LSEQ); const int kpos0 = a.kb0 + (k0 - a.na);
        if (masked && (kpos0 > iq0 + 31 + a.W || kpos0 + 63 < iq0 - a.W)) return;
        LAS unsigned char* Kb = L + buf * KBUF; LAS unsigned char* Vb = L + 4 * KBUF + buf * VBUF;
        f32x16 s0 = negm, s1 = negm;
#pragma unroll
        for (int s_ = 0; s_ < NS; ++s_) {
            const bf16x8 kf0 = *(const LAS bf16x8*)(Kb + r * KSTR + (16 * s_ + 8 * h) * 2);
            const bf16x8 kf1 = *(const LAS bf16x8*)(Kb + (32 + r) * KSTR + (16 * s_ + 8 * h) * 2);
            s0 = MFMA32(kf0, qf[s_], s0); s1 = MFMA32(kf1, qf[s_], s1); }
        if (masked && !(kpos0 >= iq0 + 31 - a.W && kpos0 + 63 <= iq0 + a.W)) {
#pragma unroll
            for (int i = 0; i < 16; ++i) { const int j = kpos0 + (i & 3) + 8 * (i >> 2) + 4 * h; const int dlt = iq - j;
                if (dlt > a.W || dlt < -a.W) s0[i] = -1e30f; if (dlt - 32 > a.W || dlt - 32 < -a.W) s1[i] = -1e30f; }
        }
        float mx = max3f(s0[0], s0[1], s0[2]);
        mx = max3f(mx, s0[3], s0[4]); mx = max3f(mx, s0[5], s0[6]); mx = max3f(mx, s0[7], s0[8]); mx = max3f(mx, s0[9], s0[10]); mx = max3f(mx, s0[11], s0[12]);
        mx = max3f(mx, s0[13], s0[14]); mx = max3f(mx, s0[15], s1[0]); mx = max3f(mx, s1[1], s1[2]); mx = max3f(mx, s1[3], s1[4]); mx = max3f(mx, s1[5], s1[6]);
        mx = max3f(mx, s1[7], s1[8]); mx = max3f(mx, s1[9], s1[10]); mx = max3f(mx, s1[11], s1[12]); mx = max3f(mx, s1[13], s1[14]); mx = max2f(mx, s1[15]);
        const bool first = (!a.has_sink) && (t == 0);
        if (first || __builtin_amdgcn_ballot_w64(mx > 8.f) != 0ull) {
            mx = max2f(mx, SHX(mx, 32));
            const float d = first ? mx : max2f(mx, 0.f); const float alpha = first ? 0.f : __builtin_amdgcn_exp2f(-d); m += d; l *= alpha;
#pragma unroll
            for (int i = 0; i < 16; ++i) { o0[i] *= alpha; o1[i] *= alpha; s0[i] -= d; s1[i] -= d; negm[i] = -m; }
        }
        f32x2 lsv = {0.f, 0.f};
#pragma unroll
        for (int i = 0; i < 16; ++i) { s0[i] = __builtin_amdgcn_exp2f(s0[i]); s1[i] = __builtin_amdgcn_exp2f(s1[i]); }
#pragma unroll
        for (int i = 0; i < 16; i += 2) { lsv += (f32x2){s0[i], s0[i + 1]}; lsv += (f32x2){s1[i], s1[i + 1]}; }
        l += lsv.x + lsv.y;
        u32x4 pw;
#pragma unroll
        for (int kh = 0; kh < 2; ++kh) {
#pragma unroll
            for (int s2 = 0; s2 < 2; ++s2) {
                if (kh == 0) { pw.x = cvtpk(s0[8 * s2], s0[8 * s2 + 1]); pw.y = cvtpk(s0[8 * s2 + 2], s0[8 * s2 + 3]); pw.z = cvtpk(s0[8 * s2 + 4], s0[8 * s2 + 5]); pw.w = cvtpk(s0[8 * s2 + 6], s0[8 * s2 + 7]); }
                else         { pw.x = cvtpk(s1[8 * s2], s1[8 * s2 + 1]); pw.y = cvtpk(s1[8 * s2 + 2], s1[8 * s2 + 3]); pw.z = cvtpk(s1[8 * s2 + 4], s1[8 * s2 + 5]); pw.w = cvtpk(s1[8 * s2 + 6], s1[8 * s2 + 7]); }
                const bf16x8 pf = __builtin_bit_cast(bf16x8, pw);
                const LAS unsigned char* vb0 = Vb + (32 * kh + 16 * s2) * VSTR + vtoff;
                { const s16x4 lo = vtr(vb0), hi = vtr(vb0 + 8 * VSTR); const bf16x8 vf = __builtin_shufflevector(lo, hi, 0, 1, 2, 3, 4, 5, 6, 7); o0 = MFMA32(vf, pf, o0); }
                { const s16x4 lo = vtr(vb0 + 64), hi = vtr(vb0 + 8 * VSTR + 64); const bf16x8 vf = __builtin_shufflevector(lo, hi, 0, 1, 2, 3, 4, 5, 6, 7); o1 = MFMA32(vf, pf, o1); }
            }
        }
    };
    GLOAD(0, kA0, kA1, vA);
    GLOAD(1, kB0, kB1, vB);
    const int ntm1 = nt - 1;
    for (int t = 0; t < nt; t += 2) {
        const int pb = t & 2;
        LSTORE(pb, kA0, kA1, vA);
        LSTORE(pb + 1, kB0, kB1, vB);
        LDS_BAR();
        { const int tn = (t + 2 < nt) ? t + 2 : ntm1; GLOAD(tn, kA0, kA1, vA); }
        { const int tn = (t + 3 < nt) ? t + 3 : ntm1; GLOAD(tn, kB0, kB1, vB); }
        compute(t, pb);
        compute(t + 1, pb + 1);
    }
#undef GLOAD
#undef LSTORE
    l += SHX(l, 32);
    const float inv = 1.f / l;
    bf16_t* orow = a.O + (size_t)(wrow + r) * a.os + hoff;
#pragma unroll
    for (int g = 0; g < 4; ++g) {
        u32x2 w0, w1; w0.x = cvtpk(o0[4 * g] * inv, o0[4 * g + 1] * inv); w0.y = cvtpk(o0[4 * g + 2] * inv, o0[4 * g + 3] * inv);
        w1.x = cvtpk(o1[4 * g] * inv, o1[4 * g + 1] * inv); w1.y = cvtpk(o1[4 * g + 2] * inv, o1[4 * g + 3] * inv);
        *(u32x2*)(orow + 8 * g + 4 * h) = w0; *(u32x2*)(orow + 32 + 8 * g + 4 * h) = w1;
    }
    __syncthreads();
}
DI void phase_swa(bf16_t* SQ, const bf16_t* SK, const bf16_t* SV, const float* sinkp, const float* qg, bool with_ctx, LAS unsigned char* L, const int WB, bf16_t* OD = nullptr) {
    const int tid = my_tid(); const int nu = 1024 + (with_ctx ? 128 : 0);
    for (int u = (int)((blockIdx.x & 7) * (gridDim.x >> 3) + (blockIdx.x >> 3)); u < nu; u += gridDim.x) {
        AttnU a; a.qs = 512; a.ks = 1024; a.vs = 128; a.os = 512; a.W = 128; a.has_sink = 1; a.qg = qg; a.qrope = 0; a.two = 0; a.sink2 = 0.f;
        if (u < 1024) { const int qb = u & 15, hp = (u >> 4) & 3, b = u >> 6; const int hq = 2 * hp, kvh = hp >> 1; const int q0 = qb * 128;
            a.two = 1; a.qrope = 1; a.sink = sinkp[hq] * LOG2E; a.sink2 = sinkp[hq + 1] * LOG2E; a.q0 = q0; a.kb0 = q0 - 128 < 0 ? 0 : q0 - 128; const int ke = q0 + 256 > LSEQ ? LSEQ : q0 + 256; a.nb = ke - a.kb0; a.na = NC;
            a.Q = SQ + (size_t)(b * LSEQ + q0) * 512 + hq * 64; a.O = SQ + (size_t)(b * LSEQ + q0) * 512 + hq * 64;
            a.KA = SK + (size_t)(NLAT + b * NC) * 1024 + kvh * 64; a.VA = SV + (size_t)(NLAT + b * NC) * 128 + kvh * 64;
            a.KB = SK + (size_t)(b * LSEQ + a.kb0) * 1024 + kvh * 64; a.VB = SV + (size_t)(b * LSEQ + a.kb0) * 128 + kvh * 64;
        } else { const int v = u - 1024; const int hq = v & 7, b = v >> 3; const int kvh = hq >> 2;
            a.sink = sinkp[hq] * LOG2E; a.q0 = 0; a.kb0 = 0; a.nb = 0; a.na = NC;
            a.Q = SQ + (size_t)(NLAT + b * NC) * 512 + hq * 64; a.O = SQ + (size_t)(NLAT + b * NC) * 512 + hq * 64;
            a.KA = SK + (size_t)(NLAT + b * NC) * 1024 + kvh * 64; a.VA = SV + (size_t)(NLAT + b * NC) * 128 + kvh * 64; a.KB = a.KA; a.VB = a.VA;
        }
        if (OD) a.O = OD + (a.O - SQ);
        attn_unit<64>(a, L, tid, WB);
    }
}
DI void phase_mla(bf16_t* QR, const bf16_t* KVR, const float* qg, bool with_ctx, LAS unsigned char* L, const int WB, bf16_t* OD = nullptr) {
    const int tid = my_tid(); const int nu = 1024 + (with_ctx ? 128 : 0);
    for (int u = (int)((blockIdx.x & 7) * (gridDim.x >> 3) + (blockIdx.x >> 3)); u < nu; u += gridDim.x) {
        AttnU a; a.qs = 768; a.ks = 1280; a.vs = 1280; a.os = 768; a.W = 1 << 20; a.has_sink = 0; a.sink = 0.f; a.q0 = 0; a.kb0 = 0; a.na = NC; a.qg = qg; a.qrope = 0; a.two = 0; a.sink2 = 0.f;
        if (u < 1024) { const int qb = u & 7, hh = (u >> 3) & 7, b = u >> 6;
            a.nb = LSEQ; a.q0 = qb * 256; a.qrope = 1; a.Q = QR + (size_t)(b * LSEQ + qb * 256) * 768 + hh * 96; a.O = a.Q ? QR + (size_t)(b * LSEQ + qb * 256) * 768 + hh * 96 : nullptr;
            a.KA = KVR + (size_t)(NLAT + b * NC) * 1280 + hh * 160; a.KB = KVR + (size_t)(b * LSEQ) * 1280 + hh * 160;
        } else { const int v = u - 1024; const int hh = v & 7, b = v >> 3;
            a.nb = 0; a.Q = QR + (size_t)(NLAT + b * NC) * 768 + hh * 96; a.O = QR + (size_t)(NLAT + b * NC) * 768 + hh * 96;
            a.KA = KVR + (size_t)(NLAT + b * NC) * 1280 + hh * 160; a.KB = a.KA;
        }
        a.VA = a.KA + 96; a.VB = a.KB + 96;
        if (OD) a.O = OD + (a.O - QR);
        attn_unit<96>(a, L, tid, WB);
    }
}

struct Args { const float* in[27]; float* out; unsigned char* ws; int ph_lo, ph_hi; };
typedef const __attribute__((address_space(4))) Args* KArgs;
DI KArgs launder(KArgs p) { asm volatile("" : "+s"(p)); return p; }
#define WSP(T, off) ((T*)(A->ws + (off)))
#ifndef PROBE_MASK
#define PROBE_MASK 0
#endif
#ifndef TS_SEL
#define TS_SEL -1
#endif
#define STAMP(id) do { if constexpr (TS_SEL >= 0) { if (blockIdx.x == 0 && my_tid() == 0) { unsigned long long* tsb_ = (unsigned long long*)(A->ws + 32768); \
        const unsigned long long now_ = __builtin_amdgcn_s_memrealtime(); tsb_[1 + (id)] += now_ - tsb_[0]; tsb_[0] = now_; } } } while (0)
DI int opaque_i(int v) { asm volatile("" : "+s"(v)); return v; }
#define REPS(bit) for (int rep_ = 0, nrep_ = (((PROBE_MASK >> (bit)) & 1) ? opaque_i(2) : 1); rep_ < nrep_; ++rep_)
#define PHASE_BEGIN { const KArgs A = launder(ap0); {
#define PHASE_END_ID(id)   GRID_BAR(); if constexpr ((PROBE_MASK >> 9) & 1) GRID_BAR(); STAMP(id); } }
#define PHASE_END_LAST } }
#define LAYER_W(l) LayerW lw; lw.w_in = A->in[7] + (size_t)(l) * 1024 * 2208; lw.w_uq = A->in[9] + (size_t)(l) * 256 * 768; lw.w_ukv = A->in[11] + (size_t)(l) * 128 * 1024; \
        lw.gate_w = A->in[16] + (size_t)(l) * 2 * 2 * 8 * 64 * 64; lw.w_out = A->in[23] + (size_t)(l) * 1536 * 1024; lw.w_ff1 = A->in[25] + (size_t)(l) * 1024 * 4096; lw.w_ff2 = A->in[26] + (size_t)(l) * 4096 * 1024;
#define PHASE_END_MAYBE if (l == 0 || TS_SEL >= 0) GRID_BAR(); STAMP(13); } }
#define XB_TMO      128
#define XB_XCNT(j)  (256  + 64 * (j))
#define XB_XSUB(j)  (1280 + 64 * (j))
#define XB_XGEN(j)  (2304 + 64 * (j))
#define XB_TOP      3328
#define XB_TOPGEN   3392
#define XCD_BAR_WORDS 3456
#define XB_SPIN_CAP (1u << 22)
DI unsigned xb_ld(unsigned* p)              { return __hip_atomic_load(p, __ATOMIC_RELAXED, __HIP_MEMORY_SCOPE_AGENT); }
DI unsigned xb_add(unsigned* p, unsigned v) { return __hip_atomic_fetch_add(p, v, __ATOMIC_RELAXED, __HIP_MEMORY_SCOPE_AGENT); }
DI unsigned xb_xcc_id() { return (unsigned)__builtin_amdgcn_s_getreg((3 << 11) | 20) & 0xFu; }
#define XB_SPIN(cond, bar) do { unsigned _sp = 0; while (cond) { __builtin_amdgcn_s_sleep(1); \
    if ((++_sp & 255u) == 0u) { if (xb_ld(&(bar)[XB_TMO])) break; if (_sp > XB_SPIN_CAP) { atomicAdd(&(bar)[XB_TMO], 1u); break; } } } } while (0)
DI void xcd_barrier_complete(unsigned* bar, unsigned x, unsigned& nloc, unsigned& nx) {
    const unsigned G = gridDim.x * gridDim.y * gridDim.z;
    unsigned sum, cnt, mine, sp = 0u;
    for (;;) {
        sum = 0u; cnt = 0u; mine = 0u;
#pragma unroll
        for (unsigned j = 0; j < 16; ++j) { const unsigned c = xb_ld(&bar[XB_XCNT(j)]); sum += c; cnt += (c > 0u) ? 1u : 0u; mine = (j == x) ? c : mine; }
        if (sum == G) break;
        __builtin_amdgcn_s_sleep(1);
        if ((++sp & 255u) == 0u) { if (xb_ld(&bar[XB_TMO])) break; if (sp > XB_SPIN_CAP) { atomicAdd(&bar[XB_TMO], 1u); break; } }
    }
    nloc = mine > 0u ? mine : 1u; nx = cnt > 0u ? cnt : 1u;
}
DI void grid_bar(unsigned* bar, volatile LAS unsigned* st, const int WB) {
    asm volatile("s_waitcnt vmcnt(0)" ::: "memory");
    __syncthreads();
    if (my_tid() == 0) {
        __builtin_amdgcn_s_waitcnt(0);
        const unsigned x = xb_xcc_id();
        unsigned nloc = st[0], nx = st[1];
        if (nloc == 0u) { xcd_barrier_complete(bar, x, nloc, nx); st[0] = nloc; st[1] = nx; }
        const unsigned old = xb_add(&bar[XB_XSUB(x)], 1u);
        const unsigned gen = old / nloc;
        if (old + 1u == (gen + 1u) * nloc) {
            __builtin_amdgcn_fence(__ATOMIC_RELEASE, "agent");
            asm volatile("s_waitcnt vmcnt(0)" ::: "memory");
            const unsigned og = xb_add(&bar[XB_TOP], 1u);
            const unsigned tg = og / nx;
            if (og + 1u == (tg + 1u) * nx) xb_add(&bar[XB_TOPGEN], 1u);
            else XB_SPIN(xb_ld(&bar[XB_TOPGEN]) == tg, bar);
            __builtin_amdgcn_fence(__ATOMIC_ACQUIRE, "agent");
            xb_add(&bar[XB_XGEN(x)], 1u);
            asm volatile("s_waitcnt vmcnt(0)" ::: "memory");
        } else {
            XB_SPIN(xb_ld(&bar[XB_XGEN(x)]) == gen, bar);
            __builtin_amdgcn_fence(__ATOMIC_ACQUIRE, "agent");
            asm volatile("s_waitcnt vmcnt(0)" ::: "memory");
        }
    }
    __syncthreads();
}
#define GRID_BAR() grid_bar(WSP(unsigned, 0), (volatile LAS unsigned*)(L + LDS_BYTES - 64), WB)
template <int l> DI void run_layer(const KArgs ap0, LAS unsigned char* L, unsigned& nbar, const int WB) {
        PHASE_BEGIN
            if (l == 1) { LAYER_W(1) phase_convert(lw, A->ws + WS_W, L, WB, 2); }
            REPS(0) phase_norm(l == 0 ? A->in[0] : A->out, l == 0 ? A->in[2] : WSP(float, WS_XCRES), l == 0 ? (const bf16_t*)nullptr : WSP(bf16_t, WS_Y2), A->out, WSP(float, WS_XCRES), WSP(bf16_t, WS_HN), A->in[6] + l * 1024, WSP(float, WS_MOD) + (size_t)l * 17 * 6144, 0, NTOK, WB);
        PHASE_END_ID(1)
        PHASE_BEGIN
            pg8::Gemm g{WSP(bf16_t, WS_HN), WSP(bf16_t, WS_W + W_IN), NTOK, PW, 1024, 1024}; pg8::WinOrder<l == 1> S; S.init(gridDim.x, blockIdx.x);
            pg8::EpiStore<0> E{WSP(bf16_t, WS_P), PW, (long long)(WS_LG - WS_P) / 2, 512, 4, 6, (long long)(WS_SQ - WS_P) / 2, 6, 8};
            REPS(1) pg8::gemm_phase<pg8::EpiStore<0>, pg8::WinOrder<l == 1>, true, true>(L, g, S, E, WB);
        PHASE_END_ID(2)
        PHASE_BEGIN
            PrepW pw{A->in[8] + l * 256, A->in[10] + l * 128, A->in[14] + l * 4 * 512, A->in[15] + l * 512, A->in[19] + l * 64, A->in[20] + l * 64};
#ifndef SK_PREP
            REPS(2) phase_prep(WSP(bf16_t, WS_P), pw, WSP(bf16_t, WS_ACT), WSP(bf16_t, WS_KR), WSP(bf16_t, WS_SV), l == 1, WB);
#endif
        PHASE_END_ID(3)
        PHASE_BEGIN
            pg8::Gemm g{WSP(bf16_t, WS_ACT), WSP(bf16_t, WS_W + W_S4), NTOK, 4096, 256, 1024}; pg8::S4Order S; S.init(NTOK, 4096, gridDim.x, blockIdx.x);
            pg8::EpiGate EG{WSP(bf16_t, WS_ACT) + 512, WSP(unsigned, WS_AU), A->in[17] + l * 2048, A->in[18] + l * 1024, NTOK};
            pg8::EpiS4 E{WSP(bf16_t, WS_QR), WSP(bf16_t, WS_KVR), EG, l == 1 ? NLAT : NTOK};
            REPS(3) pg8::gemm_phase<pg8::EpiS4, pg8::S4Order, true, true>(L, g, S, E, WB);
        PHASE_END_ID(4)
        PHASE_BEGIN
            FinW fw{A->in[12] + l * 96, A->in[13] + l * 96};
            phase_finish(WSP(bf16_t, WS_QR), WSP(bf16_t, WS_KVR), WSP(bf16_t, WS_KR), fw, 0, WB);
        PHASE_END_ID(7)
        PHASE_BEGIN
            if (blockIdx.x & 1) {
                phase_scan(WSP(unsigned, WS_AU), L, WB);
                phase_swa(WSP(bf16_t, WS_SQ), WSP(bf16_t, WS_ACT) + 384, WSP(bf16_t, WS_SV), A->in[21] + l * 8, A->in[19] + l * 64, l == 0, L, WB);
                phase_mla(WSP(bf16_t, WS_QR), WSP(bf16_t, WS_KVR), A->in[12] + l * 96, l == 0, L, WB);
            } else {
                phase_mla(WSP(bf16_t, WS_QR), WSP(bf16_t, WS_KVR), A->in[12] + l * 96, l == 0, L, WB);
                phase_swa(WSP(bf16_t, WS_SQ), WSP(bf16_t, WS_ACT) + 384, WSP(bf16_t, WS_SV), A->in[21] + l * 8, A->in[19] + l * 64, l == 0, L, WB);
                phase_scan(WSP(unsigned, WS_AU), L, WB);
            }
        PHASE_END_ID(8)
        PHASE_BEGIN
            REPS(4) phase_groupnorm(WSP(bf16_t, WS_QR), WSP(float, WS_AU), WSP(bf16_t, WS_LG), WSP(bf16_t, WS_SQ), A->in[22] + l * 1536, WSP(bf16_t, WS_ON), l == 1 ? NLAT : NTOK, WB);
        PHASE_END_ID(9)
        PHASE_BEGIN
            const int mrows = l == 1 ? NLAT : NTOK;
            pg8::Gemm g{WSP(bf16_t, WS_ON), WSP(bf16_t, WS_W + W_OUT), mrows, 1024, 1536, 1536}; pg8::StaticOrder S; S.init(mrows, 1024, gridDim.x, blockIdx.x);
            pg8::EpiDelta E{WSP(bf16_t, WS_Y1), WSP(float, WS_MOD) + (size_t)l * 17 * 6144 + 2 * 1024};
            pg8::gemm_phase<pg8::EpiDelta, pg8::StaticOrder, true, true>(L, g, S, E, WB);
            if constexpr (l == 0) { LAYER_W(0) phase_convert(lw, A->ws + WS_W, L, WB, 4); }
        PHASE_END_ID(10)
        PHASE_BEGIN
            phase_norm(l == 0 ? A->in[0] : A->out, l == 0 ? A->in[2] : WSP(float, WS_XCRES), WSP(bf16_t, WS_Y1), A->out, WSP(float, WS_XCRES), WSP(bf16_t, WS_HN), A->in[24] + l * 1024, WSP(float, WS_MOD) + (size_t)l * 17 * 6144, 3, l == 1 ? NLAT : NTOK, WB);
        PHASE_END_ID(11)
        PHASE_BEGIN
            const int mrows = l == 1 ? NLAT : NTOK;
            pg8::Gemm g{WSP(bf16_t, WS_HN), WSP(bf16_t, WS_W + W_FF1), mrows, 4096, 1024, 1024}; pg8::StaticOrder S; S.init(mrows, 4096, gridDim.x, blockIdx.x);
            pg8::EpiStore<2> E{WSP(bf16_t, WS_H), 4096}; REPS(6) pg8::gemm_phase<pg8::EpiStore<2>, pg8::StaticOrder, true, true>(L, g, S, E, WB);
        PHASE_END_ID(12)
        PHASE_BEGIN
            const int mrows = l == 1 ? NLAT : NTOK;
            pg8::Gemm g{WSP(bf16_t, WS_H), WSP(bf16_t, WS_W + W_FF2), mrows, 1024, 4096, 4096}; pg8::StaticOrder S; S.init(mrows, 1024, gridDim.x, blockIdx.x);
            if constexpr (l == 0) {
                pg8::EpiDelta E{WSP(bf16_t, WS_Y2), WSP(float, WS_MOD) + (size_t)l * 17 * 6144 + 5 * 1024};
                pg8::gemm_phase<pg8::EpiDelta, pg8::StaticOrder, true, true>(L, g, S, E, WB);
                { LAYER_W(1) phase_convert(lw, A->ws + WS_W, L, WB, 1); }
            } else {
                pg8::EpiResid E{A->out, WSP(float, WS_XCRES), A->out, WSP(float, WS_XCRES), WSP(float, WS_MOD) + (size_t)l * 17 * 6144 + 5 * 1024};
                pg8::gemm_phase<pg8::EpiResid, pg8::StaticOrder, true, true>(L, g, S, E, WB);
            }
        PHASE_END_MAYBE
}
__global__ void __launch_bounds__(NTHR, 2) fwd_megakernel(Args args_by_value) {
    extern __shared__ __attribute__((aligned(16))) unsigned char lds_raw[];
    LAS unsigned char* L = (LAS unsigned char*)lds_raw;
    cg::grid_group grid = cg::this_grid();
    const KArgs ap0 = (KArgs)__builtin_amdgcn_kernarg_segment_ptr();
    grid.sync();
    const int WB = __builtin_amdgcn_readfirstlane(threadIdx.x);
    unsigned nbar = 0;
    { volatile LAS unsigned* st = (volatile LAS unsigned*)(L + LDS_BYTES - 64); if (tid_from(WB) < 16) st[tid_from(WB)] = 0u; __syncthreads();
      if (tid_from(WB) == 0) (void)xb_add((unsigned*)ap0->ws + XB_XCNT(xb_xcc_id()), 1u); }
    if constexpr (TS_SEL >= 0) { if (blockIdx.x == 0 && tid_from(WB) == 0) { unsigned long long* tsb_ = (unsigned long long*)(ap0->ws + 32768); for (int i = 1; i < 32; ++i) tsb_[i] = 0ull; tsb_[0] = __builtin_amdgcn_s_memrealtime(); } }
    PHASE_BEGIN
#ifndef SK_MOD
        phase_mod(A->in[1], A->in[3], A->in[4], A->in[5], WSP(float, WS_MOD), L, WB);
#endif
        __syncthreads();
        LAYER_W(0)
        phase_convert(lw, A->ws + WS_W, L, WB, 3);
    PHASE_END_ID(0)
    run_layer<0>(ap0, L, nbar, WB);
    run_layer<1>(ap0, L, nbar, WB);
    if constexpr (TS_SEL >= 0) {
        if (blockIdx.x == 0) { const KArgs A = launder(ap0); const unsigned long long* tsb_ = (const unsigned long long*)(A->ws + 32768);
            unsigned long long tot = 0ull; for (int i = 1; i < 32; ++i) tot += tsb_[i];
            const unsigned long long sel = (TS_SEL >= 31) ? tot : tsb_[1 + (TS_SEL >= 31 ? 0 : TS_SEL)];
            const int n = (int)((sel * 65536ull) / tot);
            float* o = A->out; for (int i = tid_from(WB); i < n; i += NTHR) o[i] += 0.125f; }
    }
}
constexpr int N_PHASES = 23;

extern "C" void kernel_launch(void* const* d_in, const int* in_sizes, int n_in, void* d_out, int out_size, void* d_ws, size_t ws_size, hipStream_t stream) {
    static int grid = 0;
    if (grid == 0) {
        if (n_in != 27 || ws_size < WS_END) { fprintf(stderr, "kernel_launch: unexpected n_in %d / ws_size %zu\n", n_in, ws_size); grid = -1; return; }
        int dev = 0, cus = 0, per_cu = 0;
        hipGetDevice(&dev); hipDeviceGetAttribute(&cus, hipDeviceAttributeMultiprocessorCount, dev);
        if (hipFuncSetAttribute((const void*)fwd_megakernel, hipFuncAttributeMaxDynamicSharedMemorySize, LDS_BYTES) != hipSuccess) { fprintf(stderr, "kernel_launch: hipFuncSetAttribute failed\n"); grid = -1; return; }
        if (hipOccupancyMaxActiveBlocksPerMultiprocessor(&per_cu, (const void*)fwd_megakernel, NTHR, LDS_BYTES) != hipSuccess || per_cu < 1) { fprintf(stderr, "kernel_launch: occupancy query says %d\n", per_cu); per_cu = 1; }
        (void)hipGetLastError();
        grid = cus;
        if (grid != 256) { fprintf(stderr, "kernel_launch: needs a 256-CU device (got %d)\n", grid); grid = -1; return; }
    }
    if (grid < 0) return;
    if (hipMemsetAsync(d_ws, 0, 16384, stream) != hipSuccess) { fprintf(stderr, "memset failed\n"); return; }
    Args a{};
    for (int i = 0; i < 27; ++i) a.in[i] = (const float*)d_in[i];
    a.out = (float*)d_out; a.ws = (unsigned char*)d_ws; a.ph_lo = 0; a.ph_hi = N_PHASES;
    void* kargs[] = {&a};
    hipError_t e = hipLaunchCooperativeKernel((const void*)fwd_megakernel, dim3(grid), dim3(NTHR), kargs, LDS_BYTES, stream);
    if (e != hipSuccess) fprintf(stderr, "cooperative launch failed: %s (grid %d)\n", hipGetErrorString(e), grid);
}
```
